# Optimizing an MI355X kernel written in HIP

```python
import jax, jax.numpy as jnp
from jax import lax
import numpy as np

D_MODEL = 1024
BATCH = 32
SEQ = 256
DEPTH = 1
DEC_BATCH = 2
DEC_SEQ = 4096
PAST_LEN = 256

GRID_W = 64
WIDTH_A = D_MODEL // 2
HEAD_A = 128
N_HEADS_A = WIDTH_A // HEAD_A
WIDTH_B = D_MODEL - WIDTH_A
HEAD_B = 64
N_HEADS_B = WIDTH_B // HEAD_B
LORA_W = 32
LORA_A = 32
LORA_G = 96
CHUNK = 64
D_FF = 2816
CONV_W = 3
RMS_EPS = 1e-6
GN_EPS = 64e-5
DECAY_SCALE = 0.6065306597
P_A = 5 * WIDTH_A
P_B = 3 * WIDTH_B + 2 * LORA_W + LORA_A + LORA_G
P_IN = P_A + P_B

kernel_name = 'hymba_hgrn2_rwkv7_convffn_diffusion_step'


def rmsnorm(x, w):
    xf = x.astype(jnp.float32)
    y = xf * lax.rsqrt(jnp.mean(xf * xf, axis=-1, keepdims=True) + RMS_EPS)
    return (y * w.astype(jnp.float32)).astype(x.dtype)


def dwconv1d(x, w):
    C = x.shape[-1]
    return lax.conv_general_dilated(x, w[:, None, :].astype(x.dtype), (1,), 'SAME',
                                    dimension_numbers=('NWC', 'WIO', 'NWC'), feature_group_count=C)


def dwconv2d_grid(x, w):
    B, T, C = x.shape
    rows = T // GRID_W
    y = lax.conv_general_dilated(x.reshape(B, rows, GRID_W, C), w[:, :, None, :].astype(x.dtype), (1, 1), 'SAME',
                                 dimension_numbers=('NHWC', 'HWIO', 'NHWC'), feature_group_count=C)
    return y.reshape(B, T, C)


def hgrn2_chunk_scan(q, k, v, logf, s0):
    B, T, H, DK = q.shape
    DV = v.shape[-1]
    nc = T // CHUNK

    def chunks(z):
        return z.reshape(B, nc, CHUNK, H, z.shape[-1]).transpose(1, 0, 3, 2, 4)

    causal = jnp.tril(jnp.ones((CHUNK, CHUNK), dtype=bool))

    def step(S, inp):
        qc, kc, vc, gc = inp
        b = jnp.cumsum(gc, axis=-2)
        b_last = b[:, :, -1:, :]
        inter = jnp.einsum('bhtd,bhde->bhte', qc * jnp.exp(b), S)
        diff = jnp.where(causal[:, :, None], b[:, :, :, None, :] - b[:, :, None, :, :], -jnp.inf)
        scores = jnp.einsum('bhtd,bhsd,bhtsd->bhts', qc, kc, jnp.exp(diff))
        intra = jnp.einsum('bhts,bhse->bhte', scores, vc)
        S = jnp.exp(b_last)[:, :, 0, :, None] * S + jnp.einsum('bhsd,bhse->bhde', kc * jnp.exp(b_last - b), vc)
        return S, inter + intra

    S, o = lax.scan(step, s0.astype(q.dtype), tuple(chunks(z) for z in (q, k, v, logf)))
    o = o.transpose(1, 0, 3, 2, 4).reshape(B, T, H, DV)
    return o, S


def hgrn2_mixer(u_a, lb, norm_w, s0):
    B, T, _ = u_a.shape
    q, i, zf, zb, g = jnp.split(u_a, 5, axis=-1)
    heads = lambda z: z.reshape(B, T, N_HEADS_A, HEAD_A)
    flip = lambda z: jnp.flip(z, axis=1)
    q = heads(jax.nn.silu(q))
    i = heads(i)
    f_f = lb[0] + (1 - lb[0]) * jax.nn.sigmoid(zf)
    f_b = lb[1] + (1 - lb[1]) * jax.nn.sigmoid(zb)
    o_f, S_f = hgrn2_chunk_scan(q, heads(1 - f_f), i, heads(jnp.log(f_f)), s0[:, 0])
    o_b, S_b = hgrn2_chunk_scan(flip(q), flip(heads(1 - f_b)), flip(i), flip(heads(jnp.log(f_b))), s0[:, 1])
    o = o_f + flip(o_b)
    o = rmsnorm(o, norm_w.reshape(N_HEADS_A, HEAD_A)).reshape(B, T, WIDTH_A)
    return o * jax.nn.silu(g), jnp.stack([S_f, S_b], axis=1)


def rwkv7_scan(r, w, k, v, kk, a, s0):
    xs = tuple(jnp.moveaxis(z, 1, 0) for z in (r, w, k, v, kk, a))

    def step(S, inp):
        r_t, w_t, k_t, v_t, kk_t, a_t = inp
        sk = jnp.einsum('bhij,bhj->bhi', S, kk_t)
        S = (S * w_t[:, :, None, :] - sk[..., None] * (kk_t * a_t)[:, :, None, :]
             + v_t[..., None] * k_t[:, :, None, :])
        return S, jnp.einsum('bhij,bhj->bhi', S, r_t)

    S, ys = lax.scan(step, s0.astype(r.dtype), xs)
    return jnp.moveaxis(ys, 0, 1), S


def rwkv7_mixer(u_b, p, s0):
    B, T, _ = u_b.shape
    u_b = dwconv1d(u_b, p['rwkv_conv'])
    idx = [WIDTH_B, 2 * WIDTH_B, 3 * WIDTH_B, 3 * WIDTH_B + LORA_W, 3 * WIDTH_B + 2 * LORA_W,
           3 * WIDTH_B + 2 * LORA_W + LORA_A]
    r, k, v, wdf, wdb, ad, gd = jnp.split(u_b, idx, axis=-1)
    heads = lambda z: z.reshape(B, T, N_HEADS_B, HEAD_B)
    flip = lambda z: jnp.flip(z, axis=1)
    w_f = jnp.exp(-DECAY_SCALE * jax.nn.sigmoid(p['rwkv_w0'][0] + jnp.tanh(wdf) @ p['rwkv_w2'][0]))
    w_b = jnp.exp(-DECAY_SCALE * jax.nn.sigmoid(p['rwkv_w0'][1] + jnp.tanh(wdb) @ p['rwkv_w2'][1]))
    a = jax.nn.sigmoid(p['rwkv_a0'] + ad @ p['rwkv_a2'])
    g = jax.nn.sigmoid(gd) @ p['rwkv_g2']
    kk = heads(k * p['rwkv_k_k']).astype(jnp.float32)
    kk = (kk * lax.rsqrt(jnp.sum(kk * kk, axis=-1, keepdims=True) + 1e-12)).astype(u_b.dtype)
    k = k * (1 + (a - 1) * p['rwkv_k_a'])
    r, k, v, a = heads(r), heads(k), heads(v), heads(a)
    w_f, w_b = heads(w_f), heads(w_b)
    y_f, S_f = rwkv7_scan(r, w_f, k, v, kk, a, s0[:, 0])
    y_b, S_b = rwkv7_scan(flip(r), flip(w_b), flip(k), flip(v), flip(kk), flip(a), s0[:, 1])
    y = (y_f + flip(y_b)).astype(jnp.float32)
    mu = jnp.mean(y, axis=-1, keepdims=True)
    var = jnp.mean(jnp.square(y - mu), axis=-1, keepdims=True)
    yn = (y - mu) * lax.rsqrt(var + GN_EPS)
    yn = (yn * p['rwkv_ln_w'].reshape(N_HEADS_B, HEAD_B) + p['rwkv_ln_b'].reshape(N_HEADS_B, HEAD_B)).astype(u_b.dtype)
    bonus = jnp.sum(r * k * p['rwkv_r_k'].reshape(N_HEADS_B, HEAD_B), axis=-1, keepdims=True) * v
    out = (yn + bonus).reshape(B, T, WIDTH_B) * g
    return out, jnp.stack([S_f, S_b], axis=1)


def block(x, mod, s_hgrn, s_rwkv, ffn_conv_fn, p):
    shift1, scale1, gate1, shift2, scale2, gate2 = jnp.split(mod[:, None, :], 6, axis=-1)
    h = rmsnorm(x, p['norm_mix_w']) * (1 + scale1) + shift1
    u = h @ p['w_in']
    o_a, s_hgrn_new = hgrn2_mixer(u[..., :P_A], p['lb'], p['hgrn_norm_w'], s_hgrn)
    o_b, s_rwkv_new = rwkv7_mixer(u[..., P_A:], p, s_rwkv)
    x = x + gate1 * (jnp.concatenate([o_a, o_b], axis=-1) @ p['w_out'])
    h = rmsnorm(x, p['norm_ffn_w']) * (1 + scale2) + shift2
    gt = ffn_conv_fn(h @ p['ffn_w_gate']) + p['ffn_conv_b']
    x = x + gate2 * ((jax.nn.gelu(gt) * (h @ p['ffn_w_up'])) @ p['ffn_w_down'])
    return x, s_hgrn_new, s_rwkv_new


def setup_inputs(seed: int = 0) -> dict:
    key = jax.random.key(seed)
    ks = jax.random.split(key, 32)
    nrm = lambda k, shape, s: jax.random.normal(k, shape, jnp.float32) * s
    L = DEPTH
    centre = jnp.eye(CONV_W, dtype=jnp.float32)[1]
    return {
        'x_prompt': nrm(ks[0], (BATCH, SEQ, D_MODEL), 1.0),
        'x_sample': nrm(ks[1], (DEC_BATCH, DEC_SEQ, D_MODEL), 1.0),
        'state_hgrn': nrm(ks[2], (DEC_BATCH, L, 2, N_HEADS_A, HEAD_A, HEAD_A), 0.5),
        'state_rwkv': nrm(ks[3], (DEC_BATCH, L, 2, N_HEADS_B, HEAD_B, HEAD_B), 0.5),
        'c': nrm(ks[4], (DEC_BATCH, D_MODEL), 1.0),
        'c_ctx': nrm(ks[5], (D_MODEL,), 1.0),
        'ada_w': nrm(ks[6], (L, D_MODEL, 6 * D_MODEL), 0.5 * D_MODEL ** -0.5),
        'ada_b': nrm(ks[7], (L, 6 * D_MODEL), 0.02),
        'norm_mix_w': 1.0 + nrm(ks[8], (L, D_MODEL), 0.05),
        'w_in': nrm(ks[9], (L, D_MODEL, P_IN), D_MODEL ** -0.5),
        'hgrn_lb': nrm(ks[10], (L + 1, 2, WIDTH_A), 0.5),
        'hgrn_norm_w': 1.0 + nrm(ks[11], (L, WIDTH_A), 0.05),
        'rwkv_conv': nrm(ks[12], (L, CONV_W, P_B), 0.3) + centre[None, :, None],
        'rwkv_w0': nrm(ks[13], (L, 2, WIDTH_B), 1.0),
        'rwkv_w2': nrm(ks[14], (L, 2, LORA_W, WIDTH_B), 0.3 * LORA_W ** -0.5),
        'rwkv_a0': nrm(ks[15], (L, WIDTH_B), 0.5),
        'rwkv_a2': nrm(ks[16], (L, LORA_A, WIDTH_B), 0.5 * LORA_A ** -0.5),
        'rwkv_g2': nrm(ks[17], (L, LORA_G, WIDTH_B), LORA_G ** -0.5),
        'rwkv_k_k': 1.0 + nrm(ks[18], (L, WIDTH_B), 0.1),
        'rwkv_k_a': 1.0 + nrm(ks[19], (L, WIDTH_B), 0.1),
        'rwkv_r_k': nrm(ks[20], (L, WIDTH_B), 0.1),
        'rwkv_ln_w': 1.0 + nrm(ks[21], (L, WIDTH_B), 0.05),
        'rwkv_ln_b': nrm(ks[22], (L, WIDTH_B), 0.01),
        'w_out': nrm(ks[23], (L, D_MODEL, D_MODEL), D_MODEL ** -0.5),
        'norm_ffn_w': 1.0 + nrm(ks[24], (L, D_MODEL), 0.05),
        'ffn_w_gate': nrm(ks[25], (L, D_MODEL, D_FF), D_MODEL ** -0.5),
        'ffn_w_up': nrm(ks[26], (L, D_MODEL, D_FF), D_MODEL ** -0.5),
        'ffn_conv': nrm(ks[27], (L, CONV_W, CONV_W, D_FF), 1.0 / 3.0),
        'ffn_conv_b': nrm(ks[28], (L, D_FF), 0.02),
        'ffn_w_down': nrm(ks[29], (L, D_FF, D_MODEL), D_FF ** -0.5),
        'final_norm_w': 1.0 + nrm(ks[30], (D_MODEL,), 0.05),
    }


def reference(x_prompt, x_sample, state_hgrn, state_rwkv, c, c_ctx, ada_w, ada_b, norm_mix_w, w_in,
              hgrn_lb, hgrn_norm_w, rwkv_conv, rwkv_w0, rwkv_w2, rwkv_a0, rwkv_a2, rwkv_g2, rwkv_k_k,
              rwkv_k_a, rwkv_r_k, rwkv_ln_w, rwkv_ln_b, w_out, norm_ffn_w, ffn_w_gate, ffn_w_up, ffn_conv,
              ffn_conv_b, ffn_w_down, final_norm_w):
    lb_all = jnp.cumsum(jax.nn.softmax(hgrn_lb.astype(jnp.float32), axis=0), axis=0).astype(x_prompt.dtype)
    b_ctx = x_prompt.shape[0]
    zeros_h = jnp.zeros((b_ctx, 2, N_HEADS_A, HEAD_A, HEAD_A), x_prompt.dtype)
    zeros_r = jnp.zeros((b_ctx, 2, N_HEADS_B, HEAD_B, HEAD_B), x_prompt.dtype)
    xp, xs = x_prompt, x_sample
    new_h, new_r = [], []
    for l in range(DEPTH):
        p = dict(norm_mix_w=norm_mix_w[l], w_in=w_in[l], lb=lb_all[l], hgrn_norm_w=hgrn_norm_w[l],
                 rwkv_conv=rwkv_conv[l], rwkv_w0=rwkv_w0[l], rwkv_w2=rwkv_w2[l], rwkv_a0=rwkv_a0[l],
                 rwkv_a2=rwkv_a2[l], rwkv_g2=rwkv_g2[l], rwkv_k_k=rwkv_k_k[l], rwkv_k_a=rwkv_k_a[l],
                 rwkv_r_k=rwkv_r_k[l], rwkv_ln_w=rwkv_ln_w[l], rwkv_ln_b=rwkv_ln_b[l], w_out=w_out[l],
                 norm_ffn_w=norm_ffn_w[l], ffn_w_gate=ffn_w_gate[l], ffn_w_up=ffn_w_up[l],
                 ffn_conv_b=ffn_conv_b[l], ffn_w_down=ffn_w_down[l])
        conv_l = ffn_conv[l]
        mod_ctx = jax.nn.silu(c_ctx)[None, :] @ ada_w[l] + ada_b[l]
        xp, s_h, s_r = block(xp, mod_ctx, zeros_h, zeros_r, lambda z: dwconv1d(z, conv_l[1]), p)
        new_h.append(s_h)
        new_r.append(s_r)
        mod_lat = jax.nn.silu(c) @ ada_w[l] + ada_b[l]
        xs, _, _ = block(xs, mod_lat, state_hgrn[:, l], state_rwkv[:, l], lambda z: dwconv2d_grid(z, conv_l), p)
    y_prompt = rmsnorm(xp, final_norm_w)
    y_sample = rmsnorm(xs, final_norm_w)
    new_state_hgrn = jnp.stack(new_h, axis=1)
    new_state_rwkv = jnp.stack(new_r, axis=1)
    return (y_prompt, y_sample, new_state_hgrn, new_state_rwkv)
```

```cpp
#include <hip/hip_runtime.h>
#include <hip/hip_cooperative_groups.h>
#include <cstdio>
#include <cstdint>
namespace cg = cooperative_groups;

#define LAS __attribute__((address_space(3)))
typedef unsigned short bf16_t;
typedef short bf16x8 __attribute__((ext_vector_type(8)));
typedef float f32x4 __attribute__((ext_vector_type(4)));
typedef float f32x2 __attribute__((ext_vector_type(2)));
typedef unsigned u32x4 __attribute__((ext_vector_type(4)));
typedef unsigned u32x2 __attribute__((ext_vector_type(2)));

constexpr int NTOK = 16384, DM = 1024, PIN = 4288, PINP = 4352, DFF = 2816, PB = 1728;
constexpr int UW = PIN;
constexpr float DECAY_SCALE = 0.6065306597f;

constexpr size_t OFF_MOD = 0;
constexpr size_t OFF_LB = 73728;
constexpr size_t OFF_W2T = 77824;
constexpr size_t OFF_A2T = OFF_W2T + 65536;
constexpr size_t OFF_G2T = OFF_A2T + 32768;
constexpr size_t OFF_HD = OFF_G2T + 98304;
constexpr size_t OFF_WOUTT = 1048576;
constexpr size_t OFF_WGUT = OFF_WOUTT + 2097152;
constexpr size_t OFF_WDT = OFF_WGUT + 11534336;
constexpr size_t OFF_H = OFF_WDT + 5767168;
constexpr size_t OFF_U = OFF_H + 33554432;
constexpr size_t OFF_RS = OFF_U + 140509184;
constexpr size_t OFF_WINT = OFF_RS;
constexpr size_t OFF_G = OFF_U;
constexpr size_t OFF_UP = OFF_U + 92274688;
constexpr size_t OFF_BAR = OFF_RS + 67108864;
constexpr size_t OFF_AIN = OFF_BAR + 16384;
constexpr size_t WS_END = OFF_AIN + 6291456;

struct Params {
    const float* in[31];
    float* out;
    unsigned char* ws;
};
enum { I_XP = 0, I_XS, I_SH, I_SR, I_C, I_CCTX, I_ADAW, I_ADAB, I_NMIX, I_WIN, I_LB, I_HNW, I_RCONV, I_W0, I_W2, I_A0, I_A2, I_G2,
       I_KK, I_KA, I_RK, I_LNW, I_LNB, I_WOUT, I_NFFN, I_WG, I_WU, I_FCONV, I_FCB, I_WD, I_FNW };

__device__ __forceinline__ float bf2f(bf16_t b) { return __uint_as_float(((unsigned)b) << 16); }
__device__ __forceinline__ unsigned cvt_pk_bf16(float lo, float hi) { unsigned r; asm("v_cvt_pk_bf16_f32 %0, %1, %2" : "=v"(r) : "v"(lo), "v"(hi)); return r; }
__device__ __forceinline__ bf16_t f2bf(float f) { return (bf16_t)cvt_pk_bf16(f, f); }
__device__ __forceinline__ unsigned pk2(float lo, float hi) { return cvt_pk_bf16(lo, hi); }
__device__ __forceinline__ float sigmoidf_(float x) { return 1.0f / (1.0f + __expf(-x)); }
__device__ __forceinline__ float siluf_(float x) { return x * sigmoidf_(x); }
__device__ __forceinline__ float wave_sum(float v) {
#pragma unroll
    for (int o = 1; o < 64; o <<= 1) v += __shfl_xor(v, o);
    return v;
}
__device__ __forceinline__ float quad_sum(float v) {
    v += __int_as_float(__builtin_amdgcn_update_dpp(0, __float_as_int(v), 0xB1, 0xF, 0xF, true));
    v += __int_as_float(__builtin_amdgcn_update_dpp(0, __float_as_int(v), 0x4E, 0xF, 0xF, true));
    return v;
}
__device__ __forceinline__ int tid_fresh() { int t = threadIdx.x; asm volatile("" : "+v"(t)); return t; }
__device__ __forceinline__ int bid_fresh() { int t = blockIdx.x; asm volatile("" : "+s"(t)); return t; }
__device__ __forceinline__ int mod_row(int tok) { return tok < 8192 ? 0 : 1 + ((tok - 8192) >> 12); }
__device__ __forceinline__ const float* x_row(const Params& p, int tok) { return tok < 8192 ? p.in[I_XP] + (size_t)tok * DM : p.in[I_XS] + (size_t)(tok - 8192) * DM; }

__device__ __forceinline__ f32x4 mma_ll(const LAS bf16_t* A, int lda, const LAS bf16_t* Bt, int ldb, int ksteps, f32x4 acc, int fr, int fq) {
    for (int kk = 0; kk < ksteps; ++kk) {
        bf16x8 a = *(const LAS bf16x8*)(A + fr * lda + kk * 32 + fq * 8);
        bf16x8 b = *(const LAS bf16x8*)(Bt + fr * ldb + kk * 32 + fq * 8);
        acc = __builtin_amdgcn_mfma_f32_16x16x32_bf16(a, b, acc, 0, 0, 0);
    }
    return acc;
}
__device__ __forceinline__ f32x4 mma_lg(const LAS bf16_t* A, int lda, const bf16_t* Bt, int ldb, int ksteps, f32x4 acc, int fr, int fq) {
    for (int kk = 0; kk < ksteps; ++kk) {
        bf16x8 a = *(const LAS bf16x8*)(A + fr * lda + kk * 32 + fq * 8);
        bf16x8 b = *(const bf16x8*)(Bt + fr * ldb + kk * 32 + fq * 8);
        acc = __builtin_amdgcn_mfma_f32_16x16x32_bf16(a, b, acc, 0, 0, 0);
    }
    return acc;
}


#define XB_TMO      128
#define XB_XCNT(j)  (256  + 64 * (j))
#define XB_XSUB(j)  (1280 + 64 * (j))
#define XB_XGEN(j)  (2304 + 64 * (j))
#define XB_TOP      3328
#define XB_TOPGEN   3392
#define XCD_BAR_WORDS 3456
#define XB_SPIN_CAP (1u << 18)
__device__ __forceinline__ unsigned xb_ld(unsigned* p)              { return __hip_atomic_load(p, __ATOMIC_RELAXED, __HIP_MEMORY_SCOPE_AGENT); }
__device__ __forceinline__ unsigned xb_add(unsigned* p, unsigned v) { return __hip_atomic_fetch_add(p, v, __ATOMIC_RELAXED, __HIP_MEMORY_SCOPE_AGENT); }
__device__ __forceinline__ unsigned xb_xcc_id() { return (unsigned)__builtin_amdgcn_s_getreg((3 << 11) | 20) & 0xFu; }
#define XB_SPIN(cond, bar) do { unsigned _sp = 0; while (cond) { __builtin_amdgcn_s_sleep(1); \
    if ((++_sp & 255u) == 0u) { if (xb_ld(&(bar)[XB_TMO])) break; if (_sp > XB_SPIN_CAP) { atomicAdd(&(bar)[XB_TMO], 1u); break; } } } } while (0)
struct XcdBarrier { unsigned* bar; unsigned x; volatile LAS unsigned* st; };
__device__ __forceinline__ XcdBarrier xcd_barrier_post(unsigned* bar, volatile LAS unsigned* st) {
    XcdBarrier b; b.bar = bar; b.x = xb_xcc_id(); b.st = st;
    if (threadIdx.x == 0) (void)xb_add(&bar[XB_XCNT(b.x)], 1u);
    return b;
}
__device__ __forceinline__ void xcd_barrier_complete(unsigned* bar, unsigned x, unsigned& nloc, unsigned& nx) {
    const unsigned G = gridDim.x * gridDim.y * gridDim.z;
    unsigned sum, cnt, mine, sp = 0u;
    for (;;) {
        sum = 0u; cnt = 0u; mine = 0u;
#pragma unroll
        for (unsigned j = 0; j < 16; ++j) { const unsigned c = xb_ld(&bar[XB_XCNT(j)]); sum += c; cnt += (c > 0u) ? 1u : 0u; mine = (j == x) ? c : mine; }
        if (sum == G) break;
        __builtin_amdgcn_s_sleep(1);
        if ((++sp & 255u) == 0u) { if (xb_ld(&bar[XB_TMO])) break; if (sp > XB_SPIN_CAP) { atomicAdd(&bar[XB_TMO], 1u); break; } }
    }
    nloc = mine > 0u ? mine : 1u; nx = cnt > 0u ? cnt : 1u;
}
__device__ __forceinline__ void xcd_barrier(const XcdBarrier& b) {
    asm volatile("s_waitcnt vmcnt(0)" ::: "memory");
    __syncthreads();
    if (threadIdx.x == 0) {
        unsigned* bar = b.bar;
        __builtin_amdgcn_s_waitcnt(0);
        unsigned nloc = b.st[0], nx = b.st[1];
        if (nloc == 0u) { xcd_barrier_complete(bar, b.x, nloc, nx); b.st[0] = nloc; b.st[1] = nx; }
        const unsigned old = xb_add(&bar[XB_XSUB(b.x)], 1u);
        const unsigned gen = old / nloc;
        if (old + 1u == (gen + 1u) * nloc) {
            __builtin_amdgcn_fence(__ATOMIC_RELEASE, "agent");
            asm volatile("s_waitcnt vmcnt(0)" ::: "memory");
            const unsigned og = xb_add(&bar[XB_TOP], 1u);
            const unsigned tg = og / nx;
            if (og + 1u == (tg + 1u) * nx) xb_add(&bar[XB_TOPGEN], 1u);
            else XB_SPIN(xb_ld(&bar[XB_TOPGEN]) == tg, bar);
            __builtin_amdgcn_fence(__ATOMIC_ACQUIRE, "agent");
            xb_add(&bar[XB_XGEN(b.x)], 1u);
            asm volatile("s_waitcnt vmcnt(0)" ::: "memory");
        } else {
            XB_SPIN(xb_ld(&bar[XB_XGEN(b.x)]) == gen, bar);
            __builtin_amdgcn_fence(__ATOMIC_ACQUIRE, "agent");
            asm volatile("s_waitcnt vmcnt(0)" ::: "memory");
        }
    }
    __syncthreads();
}

namespace pg8 {
constexpr int BM = 256, BK = 64, HALF = 128, HTB = HALF * BK * 2, STAGE_BYTES = 8 * HTB, NXCD = 8, WGM = 8;
__device__ __forceinline__ int lds_byte(int r, int c) { const int st = (r >> 4) * 2 + (c >> 5), rr = r & 15, cc = c & 31, ob = rr * 64 + cc * 2; return st * 1024 + (ob ^ (((ob >> 9) & 1) << 5)); }
__device__ __forceinline__ void stage_rc(int b, int& R, int& C) { const int st = b / 1024, sb = b % 1024, swz = sb ^ (((sb >> 9) & 1) << 5); R = (st >> 1) * 16 + swz / 64; C = (st & 1) * 32 + (swz % 64) / 2; }
__device__ __forceinline__ int perm32(int rho) { const int n = rho >> 4, i = rho & 15; return 8 * (i >> 2) + 4 * n + (i & 3); }
struct Unit { int pm, pn; };
struct Gemm { const bf16_t* A; const bf16_t* Bt; int M, N, K; };
struct StaticOrder {
    int nM, nN, nwg, G, c;
    __device__ void init(int M, int N, int G_, int c_) { nM = M / BM; nN = N / BM; nwg = nM * nN; G = G_; c = c_; }
    __device__ bool next(int i, Unit& u) const {
        const long L = (long)i * G + c; if (L >= nwg) return false;
        int wgid = (int)L; { const int q = nwg / NXCD, r = nwg % NXCD, xcd = wgid % NXCD, off = wgid / NXCD; wgid = (xcd < r ? xcd * (q + 1) : r * (q + 1) + (xcd - r) * q) + off; }
        const int nig = WGM * nN, gid = wgid / nig, fm = gid * WGM, gsz = (nM - fm) < WGM ? (nM - fm) : WGM;
        u.pm = fm + ((wgid % nig) % gsz); u.pn = (wgid % nig) / gsz; return true;
    }
};

struct EpiU {
    static constexpr bool PERM = true;
    bf16_t* O;
    __device__ __forceinline__ void operator()(const f32x4 (&acc)[2][2][4][2], const Unit& u, int wr, int wc, int fr, int fq) const {
        const int row0 = u.pm * BM + wr * 64 + fr, col0 = u.pn * BM + wc * 32 + 8 * fq;
#pragma unroll
        for (int ai = 0; ai < 2; ++ai)
#pragma unroll
            for (int m = 0; m < 4; ++m) { bf16_t* rowp = O + (size_t)(row0 + ai * HALF + m * 16) * UW + col0;
#pragma unroll
                for (int bj = 0; bj < 2; ++bj) { const f32x4 v0 = acc[ai][bj][m][0], v1 = acc[ai][bj][m][1];
                    u32x4 w; w.x = cvt_pk_bf16(v0[0], v0[1]); w.y = cvt_pk_bf16(v0[2], v0[3]); w.z = cvt_pk_bf16(v1[0], v1[1]); w.w = cvt_pk_bf16(v1[2], v1[3]);
                    if (col0 + bj * HALF < PIN) *(u32x4*)(rowp + bj * HALF) = w; } }
    }
};
struct EpiGU {
    static constexpr bool PERM = true;
    bf16_t* G; bf16_t* UPp;
    __device__ __forceinline__ void operator()(const f32x4 (&acc)[2][2][4][2], const Unit& u, int wr, int wc, int fr, int fq) const {
        int colt = u.pn * BM; bf16_t* base = G; if (colt >= DFF) { colt -= DFF; base = UPp; }
        const int row0 = u.pm * BM + wr * 64 + fr, col0 = colt + wc * 32 + 8 * fq;
#pragma unroll
        for (int ai = 0; ai < 2; ++ai)
#pragma unroll
            for (int m = 0; m < 4; ++m) { bf16_t* rowp = base + (size_t)(row0 + ai * HALF + m * 16) * DFF + col0;
#pragma unroll
                for (int bj = 0; bj < 2; ++bj) { const f32x4 v0 = acc[ai][bj][m][0], v1 = acc[ai][bj][m][1];
                    u32x4 w; w.x = cvt_pk_bf16(v0[0], v0[1]); w.y = cvt_pk_bf16(v0[2], v0[3]); w.z = cvt_pk_bf16(v1[0], v1[1]); w.w = cvt_pk_bf16(v1[2], v1[3]);
                    *(u32x4*)(rowp + bj * HALF) = w; } }
    }
};
template <bool XIN> struct EpiRes {
    static constexpr bool PERM = false;
    float* OUT; const float* RESp; const float* xs; const float* gate;
    __device__ __forceinline__ void operator()(const f32x4 (&acc)[2][2][4][2], const Unit& u, int wr, int wc, int fr, int fq) const {
        const int row0 = u.pm * BM + wr * 64 + fr, col0 = u.pn * BM + wc * 32 + 4 * fq;
        const float* gr = gate + (size_t)mod_row(u.pm * BM) * 6144 + col0;
        f32x4 gv[2][2];
#pragma unroll
        for (int bj = 0; bj < 2; ++bj)
#pragma unroll
            for (int n = 0; n < 2; ++n) gv[bj][n] = *(const f32x4*)(gr + bj * HALF + n * 16);
        f32x4 rv[2][2][2];
        auto rowptr = [&](int g) -> const float* { const int r = row0 + (g >> 2) * HALF + (g & 3) * 16;
            const float* res = RESp + (size_t)r * DM; if (XIN) { if (r >= 8192) res = xs + (size_t)(r - 8192) * DM; } return res + col0; };
        { const float* rp = rowptr(0);
#pragma unroll
          for (int bj = 0; bj < 2; ++bj)
#pragma unroll
              for (int n = 0; n < 2; ++n) rv[0][bj][n] = *(const f32x4*)(rp + bj * HALF + n * 16); }
#pragma unroll
        for (int g = 0; g < 8; ++g) { const int ai = g >> 2, m = g & 3;
            if (g + 1 < 8) { const float* rp = rowptr(g + 1);
#pragma unroll
                for (int bj = 0; bj < 2; ++bj)
#pragma unroll
                    for (int n = 0; n < 2; ++n) rv[(g + 1) & 1][bj][n] = *(const f32x4*)(rp + bj * HALF + n * 16); }
            float* orow = OUT + (size_t)(row0 + ai * HALF + m * 16) * DM + col0;
#pragma unroll
            for (int bj = 0; bj < 2; ++bj)
#pragma unroll
                for (int n = 0; n < 2; ++n) *(f32x4*)(orow + bj * HALF + n * 16) = rv[g & 1][bj][n] + gv[bj][n] * acc[ai][bj][m][n]; }
    }
};

template <class Epi>
__device__ __forceinline__ void gemm_phase(LAS unsigned char* lds, const Gemm g, const StaticOrder& S, const Epi& E) {
    const int tid = tid_fresh(), wid = __builtin_amdgcn_readfirstlane(tid >> 6), lane = tid & 63, wr = wid >> 2, wc = wid & 3, fr = lane & 15, fq = lane >> 4;
    const int K = g.K, nt = K / BK;
    unsigned voffA[2], voffB[2];
#pragma unroll
    for (int i = 0; i < 2; ++i) { int R, C; stage_rc(tid * 16 + i * 8192, R, C); const int Rb = Epi::PERM ? ((R & ~31) + perm32(R & 31)) : R;
        voffA[i] = (unsigned)(R * K + C) * 2u; voffB[i] = (unsigned)(Rb * K + C) * 2u; }
    const size_t kstep = (size_t)(BK * 2);
    const size_t hstep = (size_t)HALF * K * 2;
    const size_t tstep = 2 * hstep;
    const unsigned ldsw = (unsigned)wid * 1024u;
    const int aoff = lds_byte(wr * 64 + fr, fq * 8), boff = lds_byte(wc * 32 + fr, fq * 8);
#define PG8_SA(b, h) (((b) * 2 + (h)) * HTB)
#define PG8_SB(b, h) ((4 + (b) * 2 + (h)) * HTB)
#define PG8_STAGE(bufoff, gbase, voff) do { _Pragma("unroll") for (int _i = 0; _i < 2; ++_i) \
        __builtin_amdgcn_global_load_lds((const unsigned*)((const char*)(gbase) + (voff)[_i]), (LAS unsigned*)(lds + (bufoff) + ldsw + _i * 8192), 16, 0, 0); } while (0)
#define PG8_LDA(dst, b, h) do { _Pragma("unroll") for (int m = 0; m < 4; ++m) _Pragma("unroll") for (int k = 0; k < 2; ++k) dst[m][k] = *(const LAS bf16x8*)(lds + PG8_SA(b, h) + aoff + m * 2048 + k * 1024); } while (0)
#define PG8_LDB(dst, b, h) do { _Pragma("unroll") for (int n = 0; n < 2; ++n) _Pragma("unroll") for (int k = 0; k < 2; ++k) dst[n][k] = *(const LAS bf16x8*)(lds + PG8_SB(b, h) + boff + n * 2048 + k * 1024); } while (0)
#define PG8_MMA(ai, bj, At, Bt) do { __builtin_amdgcn_s_setprio(1); _Pragma("unroll") for (int m = 0; m < 4; ++m) _Pragma("unroll") for (int n = 0; n < 2; ++n) _Pragma("unroll") for (int k = 0; k < 2; ++k) \
        acc[ai][bj][m][n] = __builtin_amdgcn_mfma_f32_16x16x32_bf16(Bt[n][k], At[m][k], acc[ai][bj][m][n], 0, 0, 0); __builtin_amdgcn_s_setprio(0); } while (0)
#define PG8_WAIT_V(n) asm volatile("s_waitcnt vmcnt(" #n ")" ::: "memory")
#define PG8_WAIT_L(n) asm volatile("s_waitcnt lgkmcnt(" #n ")" ::: "memory")
#define PG8_BAR __builtin_amdgcn_s_barrier()
#define PG8_SCHED __builtin_amdgcn_sched_barrier(0)
    Unit cur, nxt; int ui = 0;
    if (!S.next(0, cur)) return;
    f32x4 acc[2][2][4][2];
#pragma unroll
    for (int a = 0; a < 2; ++a)
#pragma unroll
        for (int b = 0; b < 2; ++b)
#pragma unroll
            for (int m = 0; m < 4; ++m)
#pragma unroll
                for (int n = 0; n < 2; ++n) acc[a][b][m][n] = (f32x4){0.f, 0.f, 0.f, 0.f};
    bf16x8 At[4][2], B0[2][2], B1[2][2];
    const char* cA = (const char*)g.A + (size_t)cur.pm * tstep; const char* cB = (const char*)g.Bt + (size_t)cur.pn * tstep;
    PG8_STAGE(PG8_SB(0, 0), cB, voffB); PG8_STAGE(PG8_SA(0, 0), cA, voffA); PG8_STAGE(PG8_SB(0, 1), cB + hstep, voffB); PG8_STAGE(PG8_SA(0, 1), cA + hstep, voffA);
    if (wr == 1) PG8_BAR;
    PG8_WAIT_V(4); PG8_BAR;
    PG8_STAGE(PG8_SB(1, 0), cB + kstep, voffB); PG8_STAGE(PG8_SA(1, 0), cA + kstep, voffA); PG8_STAGE(PG8_SB(1, 1), cB + hstep + kstep, voffB);
    PG8_WAIT_V(6); PG8_BAR;
    for (;;) {
        const bool has_next = S.next(ui + 1, nxt);
        const char* nA = has_next ? (const char*)g.A + (size_t)nxt.pm * tstep : cA; const char* nB = has_next ? (const char*)g.Bt + (size_t)nxt.pn * tstep : cB;
        for (int t = 0; t < nt; t += 2) {
            const bool last = (t == nt - 2);
            const char* a1 = cA + (size_t)(t + 1) * kstep;
            const char* a2 = last ? nA : cA + (size_t)(t + 2) * kstep; const char* b2 = last ? nB : cB + (size_t)(t + 2) * kstep;
            const char* a3 = a2 + kstep; const char* b3 = b2 + kstep;
            PG8_LDB(B0, 0, 0); PG8_SCHED; PG8_LDA(At, 0, 0); PG8_STAGE(PG8_SA(1, 1), a1 + hstep, voffA);
            PG8_WAIT_L(8); PG8_BAR; PG8_WAIT_L(0); PG8_MMA(0, 0, At, B0); PG8_BAR; PG8_SCHED;
            PG8_LDB(B1, 0, 1); PG8_STAGE(PG8_SB(0, 0), b2, voffB);
            PG8_BAR; PG8_WAIT_L(0); PG8_MMA(0, 1, At, B1); PG8_BAR;
            PG8_LDA(At, 0, 1); PG8_STAGE(PG8_SA(0, 0), a2, voffA);
            PG8_BAR; PG8_WAIT_L(0); PG8_MMA(1, 0, At, B0); PG8_BAR; PG8_SCHED;
            PG8_STAGE(PG8_SB(0, 1), b2 + hstep, voffB);
            PG8_WAIT_V(6); PG8_BAR; PG8_MMA(1, 1, At, B1); PG8_BAR;
            PG8_LDB(B0, 1, 0); PG8_SCHED; PG8_LDA(At, 1, 0); PG8_STAGE(PG8_SA(0, 1), a2 + hstep, voffA);
            PG8_WAIT_L(8); PG8_BAR; PG8_WAIT_L(0); PG8_MMA(0, 0, At, B0); PG8_BAR; PG8_SCHED;
            PG8_LDB(B1, 1, 1); PG8_STAGE(PG8_SB(1, 0), b3, voffB);
            PG8_BAR; PG8_WAIT_L(0); PG8_MMA(0, 1, At, B1); PG8_BAR;
            PG8_LDA(At, 1, 1); PG8_STAGE(PG8_SA(1, 0), a3, voffA);
            PG8_BAR; PG8_WAIT_L(0); PG8_MMA(1, 0, At, B0); PG8_BAR; PG8_SCHED;
            PG8_STAGE(PG8_SB(1, 1), b3 + hstep, voffB);
            PG8_WAIT_V(6); PG8_BAR; PG8_MMA(1, 1, At, B1); PG8_BAR;
        }
        E(acc, cur, wr, wc, fr, fq);
        if (!has_next) break;
#pragma unroll
        for (int a = 0; a < 2; ++a)
#pragma unroll
            for (int b = 0; b < 2; ++b)
#pragma unroll
                for (int m = 0; m < 4; ++m)
#pragma unroll
                    for (int n = 0; n < 2; ++n) acc[a][b][m][n] = (f32x4){0.f, 0.f, 0.f, 0.f};
        cur = nxt; cA = nA; cB = nB; ++ui;
    }
    PG8_WAIT_V(0);
    if (wr == 0) PG8_BAR;
    PG8_BAR;
#undef PG8_SA
#undef PG8_SB
#undef PG8_STAGE
#undef PG8_LDA
#undef PG8_LDB
#undef PG8_MMA
#undef PG8_WAIT_V
#undef PG8_WAIT_L
#undef PG8_BAR
#undef PG8_SCHED
}
}

__device__ __forceinline__ void transpose_tile(const float* W, int K, int N, bf16_t* WT, int row_off, int tile, LAS float* scr) {
    const int nb = N / 64, kb = tile / nb, nbi = tile % nb, k0 = kb * 64, n0 = nbi * 64, tid = tid_fresh();
#pragma unroll
    for (int i = 0; i < 8; ++i) { const int kk = (tid >> 6) + 8 * i, nn = tid & 63; scr[kk * 65 + nn] = W[(size_t)(k0 + kk) * N + n0 + nn]; }
    __syncthreads();
    { const int n = tid >> 3, kc = (tid & 7) * 8; const LAS float* s = scr + kc * 65 + n;
      u32x4 o; o.x = pk2(s[0], s[65]); o.y = pk2(s[2 * 65], s[3 * 65]); o.z = pk2(s[4 * 65], s[5 * 65]); o.w = pk2(s[6 * 65], s[7 * 65]);
      *(u32x4*)(WT + (size_t)(row_off + n0 + n) * K + k0 + kc) = o; }
    __syncthreads();
}
__device__ __forceinline__ void late_transposes(const Params& p, LAS unsigned char* lds, int first) {
    LAS float* scr = (LAS float*)lds;
    const int bid = blockIdx.x, G = gridDim.x;
    if (bid < first) return;
    bf16_t* WoutT = (bf16_t*)(p.ws + OFF_WOUTT); bf16_t* WguT = (bf16_t*)(p.ws + OFF_WGUT); bf16_t* WdT = (bf16_t*)(p.ws + OFF_WDT);
    constexpr int T_OUT = 16 * 16, T_G = 16 * 44, T_D = 44 * 16, T_ALL = T_OUT + 2 * T_G + T_D;
    for (int it = bid - first; it < T_ALL; it += G - first) {
        int r = it;
        if (r < T_OUT) { transpose_tile(p.in[I_WOUT], 1024, 1024, WoutT, 0, r, scr); continue; } r -= T_OUT;
        if (r < T_G) { transpose_tile(p.in[I_WG], 1024, DFF, WguT, 0, r, scr); continue; } r -= T_G;
        if (r < T_G) { transpose_tile(p.in[I_WU], 1024, DFF, WguT, DFF, r, scr); continue; } r -= T_G;
        transpose_tile(p.in[I_WD], DFF, 1024, WdT, 0, r, scr);
    }
}
__device__ __forceinline__ void phase0(const Params& p, LAS unsigned char* lds) {
    LAS float* scr = (LAS float*)lds;
    const int tid = tid_fresh(), bid = blockIdx.x, G = gridDim.x;
    bf16_t* WinT = (bf16_t*)(p.ws + OFF_WINT);
    if (bid < 96) {
        const int w = tid >> 6, lane = tid & 63, n = bid * 64 + lane;
        const float* aw = p.in[I_ADAW]; const float* cc = p.in[I_CCTX]; const float* c = p.in[I_C];
        LAS float* sc = scr + 2048;
        for (int i = tid; i < 3072; i += 512) sc[i] = siluf_(i < 1024 ? cc[i] : c[i - 1024]);
        __syncthreads();
        float a0 = 0.f, a1 = 0.f, a2 = 0.f;
        for (int k0 = w * 128; k0 < w * 128 + 128; k0 += 16) { float wv[16];
#pragma unroll
            for (int u = 0; u < 16; ++u) wv[u] = aw[(size_t)(k0 + u) * 6144 + n];
#pragma unroll
            for (int u = 0; u < 16; ++u) { a0 += sc[k0 + u] * wv[u]; a1 += sc[1024 + k0 + u] * wv[u]; a2 += sc[2048 + k0 + u] * wv[u]; } }
        scr[(w * 3 + 0) * 64 + lane] = a0; scr[(w * 3 + 1) * 64 + lane] = a1; scr[(w * 3 + 2) * 64 + lane] = a2;
        __syncthreads();
        if (tid < 192) { const int r = tid >> 6, l = tid & 63; float sacc = p.in[I_ADAB][bid * 64 + l];
#pragma unroll
            for (int ww = 0; ww < 8; ++ww) sacc += scr[(ww * 3 + r) * 64 + l];
            ((float*)(p.ws + OFF_MOD))[r * 6144 + bid * 64 + l] = sacc; }
        __syncthreads();
    }
    constexpr int T_IN = 16 * 67;
    for (int it = (bid + 160) % G; it < T_IN; it += G) transpose_tile(p.in[I_WIN], 1024, PIN, WinT, 0, it, scr);
    const int gt = bid * 512 + tid, GT = G * 512;
    for (int i = gt; i < 64 * 1024 / 8; i += GT) *(u32x4*)(WinT + (size_t)PIN * 1024 + (size_t)i * 8) = (u32x4){0u, 0u, 0u, 0u};
    for (int i = gt; i < 1024; i += GT) { const float l0 = p.in[I_LB][i], l1 = p.in[I_LB][1024 + i]; ((float*)(p.ws + OFF_LB))[i] = 1.0f / (1.0f + __expf(l1 - l0)); }
    { bf16_t* w2T = (bf16_t*)(p.ws + OFF_W2T); bf16_t* a2T = (bf16_t*)(p.ws + OFF_A2T); bf16_t* g2T = (bf16_t*)(p.ws + OFF_G2T);
      for (int i = gt; i < 2 * 512 * 32; i += GT) { const int d = i >> 14, ch = (i >> 5) & 511, l = i & 31; w2T[i] = f2bf(p.in[I_W2][(d * 32 + l) * 512 + ch]); }
      for (int i = gt; i < 512 * 32; i += GT) { const int ch = i >> 5, l = i & 31; a2T[i] = f2bf(p.in[I_A2][l * 512 + ch]); }
      for (int i = gt; i < 512 * 96; i += GT) { const int ch = i / 96, l = i % 96; g2T[i] = f2bf(p.in[I_G2][l * 512 + ch]); } }
}

__device__ __forceinline__ void phase_norm_mod(const Params& p, const float* src  , const float* nw, int shift_off, int scale_off, bf16_t* OUT) {
    const int tidf = tid_fresh(), lane = tidf & 63, gw = blockIdx.x * 8 + (tidf >> 6), NW = gridDim.x * 8;
    const float* mod = (const float*)(p.ws + OFF_MOD);
    for (int r0 = gw; r0 < NTOK; r0 += 4 * NW) {
        f32x4 v[4][4]; float s[4] = {0.f, 0.f, 0.f, 0.f};
#pragma unroll
        for (int u = 0; u < 4; ++u) { const int r = r0 + u * NW; const float* xr = src ? src + (size_t)r * DM : x_row(p, r);
#pragma unroll
            for (int j = 0; j < 4; ++j) v[u][j] = *(const f32x4*)(xr + 4 * lane + 256 * j); }
#pragma unroll
        for (int u = 0; u < 4; ++u) {
#pragma unroll
            for (int j = 0; j < 4; ++j) s[u] += v[u][j].x * v[u][j].x + v[u][j].y * v[u][j].y + v[u][j].z * v[u][j].z + v[u][j].w * v[u][j].w; }
#pragma unroll
        for (int u = 0; u < 4; ++u) { const int r = r0 + u * NW; const float* mr = mod + (size_t)mod_row(r) * 6144;
            const float rs = rsqrtf(wave_sum(s[u]) * (1.0f / DM) + 1e-6f);
#pragma unroll
            for (int j = 0; j < 4; ++j) { const int c = 4 * lane + 256 * j;
                const f32x4 w4 = *(const f32x4*)(nw + c), sc = *(const f32x4*)(mr + scale_off + c), sh = *(const f32x4*)(mr + shift_off + c);
                const f32x4 h = v[u][j] * rs * w4 * (sc + 1.0f) + sh;
                u32x2 o; o.x = pk2(h.x, h.y); o.y = pk2(h.z, h.w);
                *(u32x2*)(OUT + (size_t)r * DM + c) = o; } }
    }
}
__device__ __forceinline__ void phase_final_norm(const Params& p) {
    const int tidf = tid_fresh(), lane = tidf & 63, gw = blockIdx.x * 8 + (tidf >> 6), NW = gridDim.x * 8;
    const float* nw = p.in[I_FNW];
    for (int r0 = gw; r0 < NTOK; r0 += 4 * NW) {
        f32x4 v[4][4]; float s[4] = {0.f, 0.f, 0.f, 0.f};
#pragma unroll
        for (int u = 0; u < 4; ++u) { float* xr = p.out + (size_t)(r0 + u * NW) * DM;
#pragma unroll
            for (int j = 0; j < 4; ++j) v[u][j] = *(const f32x4*)(xr + 4 * lane + 256 * j); }
#pragma unroll
        for (int u = 0; u < 4; ++u) {
#pragma unroll
            for (int j = 0; j < 4; ++j) s[u] += v[u][j].x * v[u][j].x + v[u][j].y * v[u][j].y + v[u][j].z * v[u][j].z + v[u][j].w * v[u][j].w; }
#pragma unroll
        for (int u = 0; u < 4; ++u) { float* xr = p.out + (size_t)(r0 + u * NW) * DM;
            const float rs = rsqrtf(wave_sum(s[u]) * (1.0f / DM) + 1e-6f);
#pragma unroll
            for (int j = 0; j < 4; ++j) { const int c = 4 * lane + 256 * j; *(f32x4*)(xr + c) = v[u][j] * rs * *(const f32x4*)(nw + c); } }
    }
}

constexpr int H_LDT = 72, H_LDQ = 136, H_LDP = 72, H_LDO = 132;
template <int NQ>
__device__ __forceinline__ void hgrn_stage_load(const bf16_t* U, int g0, int h, int dir, int tid, u32x4 (&pf)[NQ / 8]) {
#pragma unroll
    for (int it = 0; it < NQ / 8; ++it) { const int idx = tid + it * 512, tl = idx / NQ, q = idx - tl * NQ;
        const int col = q < 16 ? 512 + h * 128 + q * 8 : (q < 32 ? 1024 + dir * 512 + h * 128 + (q - 16) * 8 : h * 128 + (q - 32) * 8);
        pf[it] = *(const u32x4*)(U + (size_t)(g0 + tl) * UW + col); }
}
template <int NQ>
__device__ __forceinline__ void hgrn_stage_store(LAS bf16_t* STG, int tid, const u32x4 (&pf)[NQ / 8]) {
#pragma unroll
    for (int it = 0; it < NQ / 8; ++it) { const int idx = tid + it * 512, tl = idx / NQ, q = idx - tl * NQ; *(LAS u32x4*)(STG + tl * 384 + q * 8) = pf[it]; }
}
__device__ __forceinline__ void lds_barrier() { asm volatile("s_waitcnt lgkmcnt(0)" ::: "memory"); __builtin_amdgcn_s_barrier(); asm volatile("" ::: "memory"); }
__device__ __forceinline__ void hgrn_load16(const LAS bf16_t* STG, int dir, int tg, int ch, float lbv, float (&lf)[16], float (&kv)[16], float (&vv)[16], float (&qs)[16], bool need_q) {
#pragma unroll
    for (int j = 0; j < 16; ++j) { const int s = tg * 16 + j, tl = dir ? 63 - s : s; const LAS bf16_t* ur = STG + tl * 384;
        const float z = bf2f(ur[128 + ch]); const float f = lbv + (1.0f - lbv) * sigmoidf_(z);
        lf[j] = __logf(f); kv[j] = 1.0f - f; vv[j] = bf2f(ur[ch]);
        qs[j] = need_q ? siluf_(bf2f(ur[256 + ch])) : 0.f; }
#pragma unroll
    for (int j = 1; j < 16; ++j) lf[j] += lf[j - 1];
}
__device__ __forceinline__ void hgrn_pass_a(const Params& p, LAS unsigned char* lds, int half) {
    const int tid = tid_fresh(), wave = tid >> 6, lane = tid & 63, fr = lane & 15, fq = lane >> 4;
    const bf16_t* U = (const bf16_t*)(p.ws + OFF_U); const float* lb = (const float*)(p.ws + OFF_LB);
    float* Lbuf = p.out; float* Dbuf = (float*)(p.ws + OFF_HD);
    LAS bf16_t* KlT = (LAS bf16_t*)lds; LAS bf16_t* VT = KlT + 128 * H_LDT; LAS float* tot = (LAS float*)(VT + 128 * H_LDT);
    const int NC = half ? 64 : 4, ncl = half ? 6 : 2;
    u32x4 pf[4];
    float lbn = 0.f;
    if ((int)blockIdx.x < 1024) { const int t0 = blockIdx.x; hgrn_stage_load<32>(U, half * 8192 + (t0 >> 3) * 64, (t0 >> 1) & 3, t0 & 1, tid, pf); lbn = lb[(t0 & 1) * 512 + ((t0 >> 1) & 3) * 128 + (tid & 127)]; }
    for (int task = blockIdx.x; task < 1024; task += gridDim.x) {
        const int cidx = task >> 3, h = (task >> 1) & 3, dir = task & 1;
        const int seqh = cidx >> ncl, c = cidx & (NC - 1), cp = dir ? NC - 1 - c : c;
        const int entry = ((seqh * 4 + h) * 2 + dir) * NC + cp;
        const int ch = tid & 127, tg = tid >> 7;
        float lf[16], kv[16], vv[16], qs[16];
        hgrn_stage_store<32>((LAS bf16_t*)(lds + 40960), tid, pf);
        const float lbv = lbn;
        lds_barrier();
        hgrn_load16((const LAS bf16_t*)(lds + 40960), dir, tg, ch, lbv, lf, kv, vv, qs, false);
        tot[tg * 128 + ch] = lf[15];
        lds_barrier();
        { const int nx = task + gridDim.x;
          if (nx < 1024) { hgrn_stage_load<32>(U, half * 8192 + (nx >> 3) * 64, (nx >> 1) & 3, nx & 1, tid, pf); lbn = lb[(nx & 1) * 512 + ((nx >> 1) & 3) * 128 + ch]; } }
        float off = 0.f, blast = 0.f;
#pragma unroll
        for (int t = 0; t < 4; ++t) { const float tv = tot[t * 128 + ch]; blast += tv; if (t < tg) off += tv; }
        unsigned kw[8], vw[8];
#pragma unroll
        for (int j = 0; j < 16; j += 2) { const float b0 = off + lf[j], b1 = off + lf[j + 1];
            kw[j >> 1] = pk2(kv[j] * __expf(blast - b0), kv[j + 1] * __expf(blast - b1)); vw[j >> 1] = pk2(vv[j], vv[j + 1]); }
        *(LAS u32x4*)(KlT + ch * H_LDT + tg * 16) = (u32x4){kw[0], kw[1], kw[2], kw[3]}; *(LAS u32x4*)(KlT + ch * H_LDT + tg * 16 + 8) = (u32x4){kw[4], kw[5], kw[6], kw[7]};
        *(LAS u32x4*)(VT + ch * H_LDT + tg * 16) = (u32x4){vw[0], vw[1], vw[2], vw[3]}; *(LAS u32x4*)(VT + ch * H_LDT + tg * 16 + 8) = (u32x4){vw[4], vw[5], vw[6], vw[7]};
        if (tg == 0) Dbuf[entry * 128 + ch] = __expf(blast);
        lds_barrier();
        float* Lo = Lbuf + (size_t)entry * 16384;
        for (int nt = 0; nt < 8; ++nt) {
            f32x4 acc = mma_ll(KlT + 16 * wave * H_LDT, H_LDT, VT + 16 * nt * H_LDT, H_LDT, 2, (f32x4){0.f, 0.f, 0.f, 0.f}, fr, fq);
#pragma unroll
            for (int j = 0; j < 4; ++j) Lo[(16 * wave + fq * 4 + j) * 128 + nt * 16 + fr] = acc[j];
        }
        lds_barrier();
    }
}
__device__ __forceinline__ void hgrn_pass_b(const Params& p, int half) {
    float* Lbuf = p.out; const float* Dbuf = (const float*)(p.ws + OFF_HD);
    const int NC = half ? 64 : 4, nchains = half ? 16 : 256, nb = NC / 4;
    const int G = gridDim.x, vb = half ? (blockIdx.x + G / 2) % G : blockIdx.x;
    const int gt = vb * 512 + tid_fresh(), GT = G * 512, nitems = nchains * 4096;
    if (gt >= nitems) return;
    f32x4 L[4], Ln[4]; float Dv[4], Dn[4];
#define HB_LOAD(LL, DD, ITEM, BATCH) do { const int ch_ = (ITEM) >> 12, e4_ = (ITEM) & 4095, d_ = e4_ >> 5; \
        _Pragma("unroll") for (int u = 0; u < 4; ++u) { const int en_ = ch_ * NC + (BATCH) * 4 + u; LL[u] = *(const f32x4*)(Lbuf + (size_t)en_ * 16384 + e4_ * 4); DD[u] = Dbuf[en_ * 128 + d_]; } } while (0)
    HB_LOAD(L, Dv, gt, 0);
    for (int item = gt; item < nitems; item += GT) {
        const int chain = item >> 12, e4 = item & 4095;
        const int seqh = chain >> 3, h = (chain >> 1) & 3, dir = chain & 1;
        f32x4 S = (f32x4){0.f, 0.f, 0.f, 0.f};
        if (half) S = *(const f32x4*)(p.in[I_SH] + (size_t)((seqh * 2 + dir) * 4 + h) * 16384 + e4 * 4);
        for (int bt = 0; bt < nb; ++bt) {
            const bool more_b = bt + 1 < nb, more_i = item + GT < nitems;
            if (more_b) HB_LOAD(Ln, Dn, item, bt + 1); else if (more_i) HB_LOAD(Ln, Dn, item + GT, 0);
#pragma unroll
            for (int u = 0; u < 4; ++u) { const int entry = chain * NC + bt * 4 + u; *(f32x4*)(Lbuf + (size_t)entry * 16384 + e4 * 4) = S; S = S * Dv[u] + L[u]; }
#pragma unroll
            for (int u = 0; u < 4; ++u) { L[u] = Ln[u]; Dv[u] = Dn[u]; }
        }
        if (!half) *(f32x4*)(p.out + 16777216 + (size_t)((seqh * 2 + dir) * 4 + h) * 16384 + e4 * 4) = S;
    }
#undef HB_LOAD
}
__device__ __forceinline__ void hgrn_pass_c(const Params& p, LAS unsigned char* lds, int half) {
    const int tid = tid_fresh(), wave = tid >> 6, lane = tid & 63, fr = lane & 15, fq = lane >> 4;
    const bf16_t* U = (const bf16_t*)(p.ws + OFF_U); const float* lb = (const float*)(p.ws + OFF_LB);
    const float* Lbuf = p.out; bf16_t* OCAT = (bf16_t*)(p.ws + OFF_H);
    LAS bf16_t* Qi = (LAS bf16_t*)lds; LAS bf16_t* Qm = Qi + 64 * H_LDQ; LAS bf16_t* Km = Qm + 64 * H_LDQ; LAS bf16_t* VT = Km + 64 * H_LDQ;
    LAS float* Osum = (LAS float*)(VT + 128 * H_LDT); LAS bf16_t* SsT = (LAS bf16_t*)(Osum + 64 * H_LDO); LAS bf16_t* Ps = SsT + 128 * H_LDQ; LAS float* tot = (LAS float*)(lds + 153600);
    const int NC = half ? 64 : 4, ncl = half ? 6 : 2;
    u32x4 pf[6];
    float lbn = 0.f;
    if ((int)blockIdx.x < 512) { const int t0 = blockIdx.x; hgrn_stage_load<48>(U, half * 8192 + (t0 >> 2) * 64, t0 & 3, 0, tid, pf); lbn = lb[(t0 & 3) * 128 + (tid & 127)]; }
    bf16_t gpre[16]; float nwp[2] = {0.f, 0.f};
    for (int task = blockIdx.x; task < 512; task += gridDim.x) {
        const int cidx = task >> 2, h = task & 3;
        const int seqh = cidx >> ncl, c = cidx & (NC - 1), g0 = half * 8192 + cidx * 64;
        for (int dir = 0; dir < 2; ++dir) {
            const int cp = dir ? NC - 1 - c : c, entry = ((seqh * 4 + h) * 2 + dir) * NC + cp;
            const int ch = tid & 127, tg = tid >> 7;
            {
                float lf[16], kv[16], vv[16], qs[16];
                hgrn_stage_store<48>((LAS bf16_t*)SsT, tid, pf);
                const float lbv = lbn;
                lds_barrier();
                hgrn_load16((const LAS bf16_t*)SsT, dir, tg, ch, lbv, lf, kv, vv, qs, true);
                tot[tg * 128 + ch] = lf[15];
                lds_barrier();
                float off = 0.f;
#pragma unroll
                for (int t = 0; t < 4; ++t) { const float tv = tot[t * 128 + ch]; if (t < tg) off += tv; }
                const float bmid = tot[ch] + tot[128 + ch];
                unsigned vw[8];
#pragma unroll
                for (int j = 0; j < 16; ++j) { const int s = tg * 16 + j; const float bs = off + lf[j];
                    Qi[s * H_LDQ + ch] = f2bf(qs[j] * __expf(bs)); Qm[s * H_LDQ + ch] = f2bf(qs[j] * __expf(bs - bmid)); Km[s * H_LDQ + ch] = f2bf(kv[j] * __expf(bmid - bs)); }
#pragma unroll
                for (int j = 0; j < 16; j += 2) vw[j >> 1] = pk2(vv[j], vv[j + 1]);
                *(LAS u32x4*)(VT + ch * H_LDT + tg * 16) = (u32x4){vw[0], vw[1], vw[2], vw[3]}; *(LAS u32x4*)(VT + ch * H_LDT + tg * 16 + 8) = (u32x4){vw[4], vw[5], vw[6], vw[7]};
            }
            { const float* Sp = Lbuf + (size_t)entry * 16384;
              for (int idx = tid; idx < 4096; idx += 512) { const int d = idx >> 5, e4 = (idx & 31) * 4; const f32x4 sv = *(const f32x4*)(Sp + d * 128 + e4);
                  SsT[(e4 + 0) * H_LDQ + d] = f2bf(sv.x); SsT[(e4 + 1) * H_LDQ + d] = f2bf(sv.y); SsT[(e4 + 2) * H_LDQ + d] = f2bf(sv.z); SsT[(e4 + 3) * H_LDQ + d] = f2bf(sv.w); } }
            {
                const int nt_ = dir ? task + (int)gridDim.x : task, nd_ = dir ^ 1;
                if (nt_ < 512) { hgrn_stage_load<48>(U, half * 8192 + (nt_ >> 2) * 64, nt_ & 3, nd_, tid, pf); lbn = lb[nd_ * 512 + (nt_ & 3) * 128 + (tid & 127)]; }
                if (dir) { const float* nw = p.in[I_HNW] + h * 128; nwp[0] = nw[lane]; nwp[1] = nw[64 + lane];
#pragma unroll
                    for (int q = 0; q < 8; ++q) { const bf16_t* ur = U + (size_t)(g0 + wave * 8 + q) * UW + 2048 + h * 128; gpre[2 * q] = ur[lane]; gpre[2 * q + 1] = ur[64 + lane]; } } }
            lds_barrier();
            for (int tt = 0; tt < 2; ++tt) { const int tile = wave * 2 + tt, mt = tile >> 2, nt = tile & 3;
                f32x4 acc = mma_ll(Qm + 16 * mt * H_LDQ, H_LDQ, Km + 16 * nt * H_LDQ, H_LDQ, 4, (f32x4){0.f, 0.f, 0.f, 0.f}, fr, fq);
#pragma unroll
                for (int j = 0; j < 4; ++j) { const int t = 16 * mt + fq * 4 + j, s = 16 * nt + fr; Ps[t * H_LDP + s] = f2bf(s <= t ? acc[j] : 0.f); } }
            lds_barrier();
            { const int mt = wave >> 1;
              for (int q = 0; q < 4; ++q) { const int nt = (wave & 1) * 4 + q;
                  f32x4 acc = mma_ll(Qi + 16 * mt * H_LDQ, H_LDQ, SsT + 16 * nt * H_LDQ, H_LDQ, 4, (f32x4){0.f, 0.f, 0.f, 0.f}, fr, fq);
                  acc = mma_ll(Ps + 16 * mt * H_LDP, H_LDP, VT + 16 * nt * H_LDT, H_LDT, 2, acc, fr, fq);
#pragma unroll
                  for (int j = 0; j < 4; ++j) { const int s = 16 * mt + fq * 4 + j, tl = dir ? 63 - s : s, e = 16 * nt + fr;
                      if (dir == 0) Osum[tl * H_LDO + e] = acc[j]; else Osum[tl * H_LDO + e] += acc[j]; } } }
            lds_barrier();
        }
#pragma unroll
        for (int q = 0; q < 8; ++q) { const int tl = wave * 8 + q, tok = g0 + tl;
            const float v0 = Osum[tl * H_LDO + lane], v1 = Osum[tl * H_LDO + 64 + lane];
            const float rs = rsqrtf(wave_sum(v0 * v0 + v1 * v1) * (1.0f / 128.0f) + 1e-6f);
            OCAT[(size_t)tok * DM + h * 128 + lane] = f2bf(v0 * rs * nwp[0] * siluf_(bf2f(gpre[2 * q])));
            OCAT[(size_t)tok * DM + h * 128 + 64 + lane] = f2bf(v1 * rs * nwp[1] * siluf_(bf2f(gpre[2 * q + 1]))); }
        lds_barrier();
    }
}

__device__ __forceinline__ float conv3(const bf16_t* U, const float* cw, int tok, int pos, int T, int colb) {
    const bf16_t* up = U + (size_t)tok * UW + 2560 + colb;
    float v = cw[PB + colb] * bf2f(up[0]);
    if (pos > 0) v += cw[colb] * bf2f(*(up - UW));
    if (pos < T - 1) v += cw[2 * PB + colb] * bf2f(up[UW]);
    return v;
}
constexpr int W_DIR = 77824;
constexpr int W_KAP = 0, W_KT = 8192, W_BT = 16384, W_XT = 8192  , W_A3 = 24576  , W_VT = 40960,
              W_NABK = 49152, W_AKK = 57344, W_CUM = 49152  , W_ADG = 65536, W_RB = 69632;
constexpr int W_KTT = 24576, W_BTT = 32768, W_RT = 24576, W_ARK = 32768;
constexpr int W_SMALL = 155648;
constexpr int W_AIN = W_DIR;
__device__ __forceinline__ int swz(int row, int col) { return row * 64 + ((((col >> 3) ^ row) & 7) << 3) + (col & 7); }
__device__ __forceinline__ f32x4 mma_sw(const LAS bf16_t* A, int a0, const LAS bf16_t* B, int b0, f32x4 acc, int fr, int fq) {
    const int ar = a0 + fr, br = b0 + fr;
#pragma unroll
    for (int kk = 0; kk < 2; ++kk) {
        const bf16x8 a = *(const LAS bf16x8*)(A + ar * 64 + ((((kk * 4 + fq) ^ ar) & 7) << 3));
        const bf16x8 b = *(const LAS bf16x8*)(B + br * 64 + ((((kk * 4 + fq) ^ br) & 7) << 3));
        acc = __builtin_amdgcn_mfma_f32_16x16x32_bf16(a, b, acc, 0, 0, 0); }
    return acc;
}
__device__ __forceinline__ f32x4 mma_sw_reg(const LAS bf16_t* A, int a0, const bf16x8 (&bfrag)[2], f32x4 acc, int fr, int fq) {
    const int ar = a0 + fr;
#pragma unroll
    for (int kk = 0; kk < 2; ++kk) {
        const bf16x8 a = *(const LAS bf16x8*)(A + ar * 64 + ((((kk * 4 + fq) ^ ar) & 7) << 3));
        acc = __builtin_amdgcn_mfma_f32_16x16x32_bf16(a, bfrag[kk], acc, 0, 0, 0); }
    return acc;
}
__device__ __forceinline__ void rwkv_ain_phase(const Params& p, LAS unsigned char* lds) {
    const bf16_t* U = (const bf16_t*)(p.ws + OFF_U); const float* cw = p.in[I_RCONV]; bf16_t* AinG = (bf16_t*)(p.ws + OFF_AIN);
    LAS bf16_t* UBs = (LAS bf16_t*)lds; LAS float* CWs = (LAS float*)(lds + 25344);
    for (int cg = blockIdx.x; cg < 256; cg += gridDim.x) {
        const int tid = tid_fresh(), half = cg >> 7, T = half ? 4096 : 256, g0 = cg * 64, t0 = (g0 - half * 8192) & (T - 1);
#pragma unroll
        for (int it = 0; it < 4; ++it) { const int idx = tid + it * 512;
            if (idx < 66 * 24) { const int rr = idx / 24, q = idx - rr * 24, pos = t0 - 1 + rr;
                u32x4 val = (u32x4){0u, 0u, 0u, 0u};
                if (pos >= 0 && pos < T) val = *(const u32x4*)(U + (size_t)(g0 - 1 + rr) * UW + 2560 + 1536 + q * 8);
                *(LAS u32x4*)(UBs + rr * 192 + q * 8) = val; } }
        for (int idx = tid; idx < 3 * 192; idx += 512) { const int tap = idx / 192, cc = idx - tap * 192; CWs[idx] = cw[tap * PB + 1536 + cc]; }
        __syncthreads();
#pragma unroll 4
        for (int it = 0; it < 24; ++it) { const int idx = tid + it * 512, t = idx / 192, l = idx - t * 192;
            float v = CWs[l] * bf2f(UBs[t * 192 + l]) + CWs[192 + l] * bf2f(UBs[(t + 1) * 192 + l]) + CWs[384 + l] * bf2f(UBs[(t + 2) * 192 + l]);
            if (l < 64) v = 1.0f - 2.0f / (1.0f + __expf(2.0f * v)); else if (l >= 96) v = sigmoidf_(v);
            AinG[(size_t)cg * 12288 + idx] = f2bf(v); }
        __syncthreads();
    }
}
template <bool PC>
__device__ __forceinline__ void rwkv_wy(const Params& p, LAS unsigned char* lds, int half) {
    const bf16_t* U = (const bf16_t*)(p.ws + OFF_U); const float* cw = p.in[I_RCONV];
    float* RS = (float*)(p.ws + OFF_RS); bf16_t* OCAT = (bf16_t*)(p.ws + OFF_H);
    const bf16_t* w2T = (const bf16_t*)(p.ws + OFF_W2T); const bf16_t* a2T = (const bf16_t*)(p.ws + OFF_A2T); const bf16_t* g2T = (const bf16_t*)(p.ws + OFF_G2T);
    LAS bf16_t* Ain = (LAS bf16_t*)(lds + W_AIN);
    LAS float* WcC = (LAS float*)(lds + W_SMALL); LAS float* RSUM = WcC + 128; LAS float* SEG = WcC + 192;
    const int NC = half ? 64 : 4, ncl = half ? 6 : 2, T = half ? 4096 : 256;
    const f32x4 z4 = (f32x4){0.f, 0.f, 0.f, 0.f};
    u32x4 pu[4], pa[3]; float pw[2];
#define RW_LOAD(TASK_) do { const int tid_ = tid_fresh(), cx_ = (TASK_) >> 3, hh_ = (TASK_) & 7, g0_ = half * 8192 + cx_ * 64, t0_ = (cx_ * 64) & (T - 1); \
        const bf16_t* AinG_ = (const bf16_t*)(p.ws + OFF_AIN) + (size_t)(half * 128 + cx_) * 12288; \
        _Pragma("unroll") for (int it = 0; it < 4; ++it) { const int idx = tid_ + it * 512, rr = idx / 24, q = idx - rr * 24, pos = t0_ - 1 + rr; \
            pu[it] = (u32x4){0u, 0u, 0u, 0u}; \
            if (idx < 66 * 24 && pos >= 0 && pos < T) pu[it] = *(const u32x4*)(U + (size_t)(g0_ - 1 + rr) * UW + 2560 + (q >> 3) * 512 + hh_ * 64 + (q & 7) * 8); } \
        _Pragma("unroll") for (int it = 0; it < 3; ++it) { const int idx = tid_ + it * 512, t = idx / 24, q = idx - t * 24; pa[it] = *(const u32x4*)(AinG_ + t * 192 + q * 8); } \
        _Pragma("unroll") for (int it = 0; it < 2; ++it) { const int idx = tid_ + it * 512, tap = idx / 192, cc = idx - tap * 192; \
            pw[it] = idx < 3 * 192 ? cw[tap * PB + (cc >> 6) * 512 + hh_ * 64 + (cc & 63)] : 0.f; } } while (0)
#define RW_SYNC() do { if (PC) __syncthreads(); else lds_barrier(); } while (0)
    bf16x8 lf0[4], lf1[4]; int hcur = -1;
    if (!PC && (int)blockIdx.x < 1024) RW_LOAD((int)blockIdx.x);
    for (int task = blockIdx.x; task < 1024; task += gridDim.x) {
        const int tid = tid_fresh(), wave = tid >> 6, lane = tid & 63, fr = lane & 15, fq = lane >> 4;
        const int mt = wave & 3, hf = wave >> 2;
        const int dir = wave >> 2, wd = wave & 3;
        LAS unsigned char* D = lds + dir * W_DIR;
        const int cidx = task >> 3, h = task & 7, seqh = cidx >> ncl, c = cidx & (NC - 1), g0 = half * 8192 + cidx * 64, t0 = (cidx * 64) & (T - 1);
        if (h != hcur) { hcur = h;
#pragma unroll
            for (int nt = 0; nt < 4; ++nt) { const size_t rowb = (size_t)(h * 64 + nt * 16 + fr) * 32 + fq * 8;
                if (hf == 0) { lf0[nt] = *(const bf16x8*)(w2T + rowb); lf1[nt] = *(const bf16x8*)(w2T + (size_t)512 * 32 + rowb); }
                else { lf0[nt] = *(const bf16x8*)(a2T + rowb); lf1[nt] = lf0[nt]; } } }
        if (PC) RW_LOAD(task);
        {   LAS bf16_t* UBs = (LAS bf16_t*)lds; LAS float* CWs = (LAS float*)(lds + 50688);
#pragma unroll
            for (int it = 0; it < 4; ++it) { const int idx = tid + it * 512, rr = idx / 24, q = idx - rr * 24; if (idx < 66 * 24) *(LAS u32x4*)(UBs + rr * 384 + q * 8) = pu[it]; }
#pragma unroll
            for (int it = 0; it < 3; ++it) { const int idx = tid + it * 512, t = idx / 24, q = idx - t * 24; *(LAS u32x4*)(Ain + t * 200 + q * 8) = pa[it]; }
#pragma unroll
            for (int it = 0; it < 2; ++it) { const int idx = tid + it * 512, tap = idx / 192, cc = idx - tap * 192; if (idx < 3 * 192) CWs[tap * 384 + cc] = pw[it]; }
        }
        RW_SYNC();
#define CONVL(t_, c_) (((const LAS float*)(lds + 50688))[c_] * bf2f(((const LAS bf16_t*)lds)[(t_) * 384 + (c_)]) + ((const LAS float*)(lds + 50688))[384 + (c_)] * bf2f(((const LAS bf16_t*)lds)[((t_) + 1) * 384 + (c_)]) + ((const LAS float*)(lds + 50688))[768 + (c_)] * bf2f(((const LAS bf16_t*)lds)[((t_) + 2) * 384 + (c_)]))
        float q0[4][4], q1[4][4], q2[4][4];
        float lwf[4][4], lwb[4][4];
        if (hf == 0) {
            const float* w0 = p.in[I_W0];
#pragma unroll
            for (int nt = 0; nt < 4; ++nt) { const int chl = nt * 16 + fr, hc = h * 64 + chl;
                const f32x4 af = __builtin_amdgcn_mfma_f32_16x16x32_bf16(*(const LAS bf16x8*)(Ain + (16 * mt + fr) * 200 + fq * 8), lf0[nt], z4, 0, 0, 0);
                const f32x4 ab = __builtin_amdgcn_mfma_f32_16x16x32_bf16(*(const LAS bf16x8*)(Ain + (16 * mt + fr) * 200 + 32 + fq * 8), lf1[nt], z4, 0, 0, 0);
                f32x4 ag = z4; if (PC) ag = mma_lg(Ain + 16 * mt * 200 + 96, 200, g2T + (size_t)(hc - fr) * 96, 96, 3, z4, fr, fq);
                const float w0f = w0[hc], w0b = w0[512 + hc];
#pragma unroll
                for (int j = 0; j < 4; ++j) { const int t = 16 * mt + fq * 4 + j;
                    lwf[nt][j] = -DECAY_SCALE * sigmoidf_(w0f + af[j]); lwb[nt][j] = -DECAY_SCALE * sigmoidf_(w0b + ab[j]);
                    q0[nt][j] = CONVL(t, 128 + chl);
                    q1[nt][j] = PC ? CONVL(t, chl) : 0.f; q2[nt][j] = ag[j]; } }
        } else {
            float ssq[4] = {0.f, 0.f, 0.f, 0.f};
#pragma unroll
            for (int nt = 0; nt < 4; ++nt) { const int chl = nt * 16 + fr, hc = h * 64 + chl;
                const f32x4 aa = __builtin_amdgcn_mfma_f32_16x16x32_bf16(*(const LAS bf16x8*)(Ain + (16 * mt + fr) * 200 + 64 + fq * 8), lf0[nt], z4, 0, 0, 0);
                const float a0 = p.in[I_A0][hc], k_k = p.in[I_KK][hc], k_a = p.in[I_KA][hc];
#pragma unroll
                for (int j = 0; j < 4; ++j) { const int t = 16 * mt + fq * 4 + j;
                    const float kraw = CONVL(t, 64 + chl), a = sigmoidf_(a0 + aa[j]);
                    q2[nt][j] = kraw * (1.0f + (a - 1.0f) * k_a); q0[nt][j] = kraw * k_k; q1[nt][j] = a; ssq[j] += q0[nt][j] * q0[nt][j];
                    lwf[nt][j] = 0.f; lwb[nt][j] = 0.f; } }
#pragma unroll
            for (int j = 0; j < 4; ++j) { float sq = ssq[j]; sq += __shfl_xor(sq, 1); sq += __shfl_xor(sq, 2); sq += __shfl_xor(sq, 4); sq += __shfl_xor(sq, 8); ssq[j] = rsqrtf(sq + 1e-12f); }
#pragma unroll
            for (int nt = 0; nt < 4; ++nt)
#pragma unroll
                for (int j = 0; j < 4; ++j) { q0[nt][j] *= ssq[j]; q1[nt][j] *= q0[nt][j]; }
        }
        RW_SYNC();
        if (!PC) { const int nx = task + (int)gridDim.x; if (nx < 1024) RW_LOAD(nx); }
        if (hf == 0) {
#pragma unroll
            for (int nt = 0; nt < 4; ++nt)
#pragma unroll
                for (int j = 0; j < 4; ++j) { const int t = 16 * mt + fq * 4 + j, chl = nt * 16 + fr;
                    ((LAS float*)(lds + W_CUM))[t * 64 + chl] = lwf[nt][j]; ((LAS float*)(lds + W_DIR + W_CUM))[(63 - t) * 64 + chl] = lwb[nt][j];
                    if (PC) ((LAS float*)(lds + W_RB))[t * 64 + chl] = q1[nt][j] * p.in[I_RK][h * 64 + chl]; }
        }
        RW_SYNC();
        {
            const int chl = tid & 63, dd = (tid >> 6) & 1, sg = tid >> 7; LAS float* C = (LAS float*)(lds + dd * W_DIR + W_CUM);
            float cs[16];
#pragma unroll
            for (int u = 0; u < 16; ++u) { cs[u] = C[(sg * 16 + u) * 64 + chl]; if (u) cs[u] += cs[u - 1]; }
            SEG[(dd * 4 + sg) * 64 + chl] = cs[15];
            if (PC && hf == 1) {
                float part[4] = {0.f, 0.f, 0.f, 0.f};
#pragma unroll
                for (int nt = 0; nt < 4; ++nt)
#pragma unroll
                    for (int j = 0; j < 4; ++j) part[j] += ((LAS float*)(lds + W_RB))[(16 * mt + fq * 4 + j) * 64 + nt * 16 + fr] * q2[nt][j];
#pragma unroll
                for (int j = 0; j < 4; ++j) { float sq = part[j]; sq += __shfl_xor(sq, 1); sq += __shfl_xor(sq, 2); sq += __shfl_xor(sq, 4); sq += __shfl_xor(sq, 8); if (fr == 0) RSUM[16 * mt + fq * 4 + j] = sq; }
            }
            RW_SYNC();
            float off = 0.f;
#pragma unroll
            for (int g = 0; g < 4; ++g) if (g < sg) off += SEG[(dd * 4 + g) * 64 + chl];
#pragma unroll
            for (int u = 0; u < 16; ++u) C[(sg * 16 + u) * 64 + chl] = cs[u] + off;
            if (sg == 3) WcC[dd * 64 + chl] = __expf(cs[15] + off);
        }
        RW_SYNC();
#pragma unroll
        for (int dd = 0; dd < 2; ++dd) { LAS unsigned char* R = lds + dd * W_DIR; const LAS float* C = (const LAS float*)(R + W_CUM);
#pragma unroll
            for (int nt = 0; nt < 4; ++nt)
#pragma unroll
                for (int j = 0; j < 4; ++j) { const int t = 16 * mt + fq * 4 + j, chl = nt * 16 + fr, sp = dd ? 63 - t : t;
                    const float c1 = C[sp * 64 + chl];
                    if (hf == 0) {
                        ((LAS bf16_t*)(R + W_VT))[swz(chl, sp)] = f2bf(q0[nt][j]);
                        if (PC) ((LAS bf16_t*)(R + W_RT))[swz(sp, chl)] = f2bf(q1[nt][j] * __expf(c1));
                    } else {
                        const float c0 = sp ? C[(sp - 1) * 64 + chl] : 0.f, e1 = __expf(-c1);
                        ((LAS bf16_t*)(R + W_KAP))[swz(sp, chl)] = f2bf(q0[nt][j] * __expf(c0));
                        const bf16_t kt = f2bf(q2[nt][j] * e1), bt = f2bf(q1[nt][j] * e1);
                        ((LAS bf16_t*)(R + W_KT))[swz(sp, chl)] = kt; ((LAS bf16_t*)(R + W_BT))[swz(sp, chl)] = bt;
                        if (!PC) { ((LAS bf16_t*)(R + W_KTT))[swz(chl, sp)] = kt; ((LAS bf16_t*)(R + W_BTT))[swz(chl, sp)] = bt; }
                    } } }
        RW_SYNC();
        {   LAS bf16_t* KAP = (LAS bf16_t*)(D + W_KAP); LAS bf16_t* KT = (LAS bf16_t*)(D + W_KT); LAS bf16_t* BT = (LAS bf16_t*)(D + W_BT);
            LAS bf16_t* NABK = (LAS bf16_t*)(D + W_NABK); LAS bf16_t* AKK = (LAS bf16_t*)(D + W_AKK); LAS float* ADG = (LAS float*)(D + W_ADG);
            const int t = 16 * wd + fr;
#pragma unroll
            for (int nt = 0; nt < 4; ++nt) { const int s0 = 16 * nt + 4 * fq;
                const int aoff = t * 64 + ((((2 * nt + (fq >> 1)) ^ t) & 7) << 3) + (fq & 1) * 4;
                f32x4 akk = mma_sw(KT, 16 * nt, KAP, 16 * wd, z4, fr, fq), abk = mma_sw(BT, 16 * nt, KAP, 16 * wd, z4, fr, fq);
#pragma unroll
                for (int r = 0; r < 4; ++r) { const bool lo = s0 + r < t; akk[r] = lo ? akk[r] : 0.f; abk[r] = lo ? abk[r] : 0.f; }
                *(LAS u32x2*)(AKK + aoff) = (u32x2){pk2(akk[0], akk[1]), pk2(akk[2], akk[3])};
                if (nt == wd) { *(LAS f32x4*)(ADG + (wd * 16 + fr) * 16 + 4 * fq) = abk; *(LAS u32x2*)(NABK + aoff) = (u32x2){0u, 0u}; }
                else *(LAS u32x2*)(NABK + aoff) = (u32x2){pk2(-abk[0], -abk[1]), pk2(-abk[2], -abk[3])};
                if (PC) { LAS bf16_t* RT = (LAS bf16_t*)(D + W_RT);
                    f32x4 ark = mma_sw(KT, 16 * nt, RT, 16 * wd, z4, fr, fq), arb = mma_sw(BT, 16 * nt, RT, 16 * wd, z4, fr, fq);
#pragma unroll
                    for (int r = 0; r < 4; ++r) { const bool le = s0 + r <= t; ark[r] = le ? ark[r] : 0.f; lwf[nt][r] = le ? -arb[r] : 0.f; }
                    *(LAS u32x2*)((LAS bf16_t*)(D + W_ARK) + aoff) = (u32x2){pk2(ark[0], ark[1]), pk2(ark[2], ark[3])}; }
            } }
        RW_SYNC();
        {   LAS unsigned* X32 = (LAS unsigned*)(D + W_XT);
            if (PC) { for (int i = (tid & 255); i < 2048; i += 256) X32[i] = 0u;
                const int t = 16 * wd + fr;
#pragma unroll
                for (int nt = 0; nt < 4; ++nt)
                    *(LAS u32x2*)((LAS bf16_t*)(D + W_BT) + t * 64 + ((((2 * nt + (fq >> 1)) ^ t) & 7) << 3) + (fq & 1) * 4) = (u32x2){pk2(lwf[nt][0], lwf[nt][1]), pk2(lwf[nt][2], lwf[nt][3])};
            } else { for (int i = (tid & 255); i < 4096; i += 256) X32[i] = 0u; }
            if (wd == 0) { LAS float* ADG = (LAS float*)(D + W_ADG); const int bb = lane >> 4, cc = lane & 15;
                float tv[16];
#pragma unroll
                for (int tl = 0; tl < 16; ++tl) { float v = (tl == cc) ? 1.f : 0.f;
#pragma unroll
                    for (int sl = 0; sl < tl; ++sl) v -= ADG[(bb * 16 + tl) * 16 + sl] * tv[sl];
                    tv[tl] = v; }
                asm volatile("s_waitcnt lgkmcnt(0)" ::: "memory");
#pragma unroll
                for (int tl = 0; tl < 16; ++tl) ADG[(bb * 16 + tl) * 16 + cc] = tv[tl]; }
        }
        const int cp = dir ? NC - 1 - c : c, entry = ((seqh * 8 + h) * 2 + dir) * NC + cp;
        float* E = RS + (size_t)entry * 8192;
        bf16x8 zw[2];
        if (PC) {
#pragma unroll
            for (int kk = 0; kk < 2; ++kk) { const float* sp = E + (16 * wd + fr) * 64 + kk * 32 + fq * 8; const f32x4 x0 = *(const f32x4*)sp, x1 = *(const f32x4*)(sp + 4);
                u32x4 w; w.x = pk2(x0.x, x0.y); w.y = pk2(x0.z, x0.w); w.z = pk2(x1.x, x1.y); w.w = pk2(x1.z, x1.w); zw[kk] = __builtin_bit_cast(bf16x8, w); }
        }
        RW_SYNC();
        {   LAS bf16_t* KAP = (LAS bf16_t*)(D + W_KAP); LAS bf16_t* NABK = (LAS bf16_t*)(D + W_NABK); LAS bf16_t* AKK = (LAS bf16_t*)(D + W_AKK); LAS bf16_t* VT = (LAS bf16_t*)(D + W_VT);
            LAS bf16_t* XT = (LAS bf16_t*)(D + W_XT); LAS float* ADG = (LAS float*)(D + W_ADG); LAS float* RB = (LAS float*)(D + W_RB);
            for (int b = 0; b < 4; ++b) {
                if (PC) {
                    f32x4 acc = mma_sw_reg(KAP, 16 * b, zw, z4, fr, fq);
                    acc = mma_sw(AKK, 16 * b, VT, 16 * wd, acc, fr, fq);
                    acc = mma_sw(NABK, 16 * b, XT, 16 * wd, acc, fr, fq);
#pragma unroll
                    for (int r = 0; r < 4; ++r) RB[(fq * 4 + r) * 64 + 16 * wd + fr] = acc[r];
                } else {
                    f32x4 a0 = mma_sw(NABK, 16 * b, XT, 16 * wd, z4, fr, fq);
                    f32x4 a1 = mma_sw(AKK, 16 * b, VT, 16 * wd, z4, fr, fq);
                    a1 = mma_sw(NABK, 16 * b, XT, 64 + 16 * wd, a1, fr, fq);
#pragma unroll
                    for (int r = 0; r < 4; ++r) { RB[(fq * 4 + r) * 128 + 16 * wd + fr] = a0[r] + bf2f(KAP[swz(16 * b + 4 * fq + r, 16 * wd + fr)]); RB[(fq * 4 + r) * 128 + 64 + 16 * wd + fr] = a1[r]; }
                }
                asm volatile("s_waitcnt lgkmcnt(0)" ::: "memory");
                {
                    constexpr int RBW = PC ? 64 : 128;
#pragma unroll
                    for (int q = 0; q < (PC ? 1 : 2); ++q) { const int col0 = q * 64 + 16 * wd; f32x4 x = z4;
#pragma unroll
                        for (int kk = 0; kk < 4; ++kk) x = __builtin_amdgcn_mfma_f32_16x16x4f32(ADG[(16 * b + fr) * 16 + 4 * kk + fq], RB[(4 * kk + fq) * RBW + col0 + fr], x, 0, 0, 0);
                        const int col = col0 + fr;
                        *(LAS u32x2*)(XT + col * 64 + ((((2 * b + (fq >> 1)) ^ col) & 7) << 3) + (fq & 1) * 4) = (u32x2){pk2(x[0], x[1]), pk2(x[2], x[3])}; } }
                asm volatile("s_waitcnt lgkmcnt(0)" ::: "memory");
            }
            RW_SYNC();
            if (!PC) {
                LAS bf16_t* KTT = (LAS bf16_t*)(D + W_KTT); LAS bf16_t* BTT = (LAS bf16_t*)(D + W_BTT);
#pragma unroll
                for (int nt = 0; nt < 4; ++nt) { const float wc = WcC[dir * 64 + 16 * nt + fr];
                    const f32x4 qp = mma_sw(XT, 16 * wd, BTT, 16 * nt, z4, fr, fq);
                    const f32x4 l1 = mma_sw(VT, 16 * wd, KTT, 16 * nt, z4, fr, fq);
                    const f32x4 l2 = mma_sw(XT, 64 + 16 * wd, BTT, 16 * nt, z4, fr, fq);
#pragma unroll
                    for (int r = 0; r < 4; ++r) { const int m = 16 * wd + fq * 4 + r, jj = 16 * nt + fr;
                        E[4096 + m * 64 + jj] = ((m == jj ? 1.f : 0.f) - qp[r]) * wc; E[m * 64 + jj] = (l1[r] - l2[r]) * wc; } }
            } else {
                LAS bf16_t* RT = (LAS bf16_t*)(D + W_RT); LAS bf16_t* ARK = (LAS bf16_t*)(D + W_ARK); LAS bf16_t* NARB = (LAS bf16_t*)(D + W_BT);
                f32x4 y[4];
#pragma unroll
                for (int nt = 0; nt < 4; ++nt) { bf16x8 zf[2];
#pragma unroll
                    for (int kk = 0; kk < 2; ++kk) { const float* sp = E + (16 * nt + fr) * 64 + kk * 32 + fq * 8; const f32x4 x0 = *(const f32x4*)sp, x1 = *(const f32x4*)(sp + 4);
                        u32x4 w; w.x = pk2(x0.x, x0.y); w.y = pk2(x0.z, x0.w); w.z = pk2(x1.x, x1.y); w.w = pk2(x1.z, x1.w); zf[kk] = __builtin_bit_cast(bf16x8, w); }
                    y[nt] = mma_sw_reg(RT, 16 * wd, zf, z4, fr, fq);
                    y[nt] = mma_sw(ARK, 16 * wd, VT, 16 * nt, y[nt], fr, fq); y[nt] = mma_sw(NARB, 16 * wd, XT, 16 * nt, y[nt], fr, fq); }
                RW_SYNC();
                LAS float* Yd = (LAS float*)(D + W_NABK);
#pragma unroll
                for (int nt = 0; nt < 4; ++nt)
#pragma unroll
                    for (int r = 0; r < 4; ++r) { const int sp = 16 * wd + fq * 4 + r, t = dir ? 63 - sp : sp; Yd[t * 64 + 16 * nt + fr] = y[nt][r]; }
            }
        }
        RW_SYNC();
        if (PC && hf == 0) {
            const LAS float* Yf = (const LAS float*)(lds + W_NABK); const LAS float* Yb = (const LAS float*)(lds + W_DIR + W_NABK);
            float yv[4][4], mu[4] = {0.f, 0.f, 0.f, 0.f}, var[4] = {0.f, 0.f, 0.f, 0.f};
#pragma unroll
            for (int nt = 0; nt < 4; ++nt)
#pragma unroll
                for (int j = 0; j < 4; ++j) { const int t = 16 * mt + fq * 4 + j, chl = nt * 16 + fr; yv[nt][j] = Yf[t * 64 + chl] + Yb[t * 64 + chl]; mu[j] += yv[nt][j]; }
#pragma unroll
            for (int j = 0; j < 4; ++j) { float sq = mu[j]; sq += __shfl_xor(sq, 1); sq += __shfl_xor(sq, 2); sq += __shfl_xor(sq, 4); sq += __shfl_xor(sq, 8); mu[j] = sq * (1.0f / 64.0f); }
#pragma unroll
            for (int nt = 0; nt < 4; ++nt)
#pragma unroll
                for (int j = 0; j < 4; ++j) { const float dl = yv[nt][j] - mu[j]; var[j] += dl * dl; }
#pragma unroll
            for (int j = 0; j < 4; ++j) { float sq = var[j]; sq += __shfl_xor(sq, 1); sq += __shfl_xor(sq, 2); sq += __shfl_xor(sq, 4); sq += __shfl_xor(sq, 8); var[j] = rsqrtf(sq * (1.0f / 64.0f) + 64e-5f); }
#pragma unroll
            for (int nt = 0; nt < 4; ++nt) { const int hc = h * 64 + nt * 16 + fr; const float lnw = p.in[I_LNW][hc], lnb = p.in[I_LNB][hc];
#pragma unroll
                for (int j = 0; j < 4; ++j) { const int t = 16 * mt + fq * 4 + j;
                    const float yn = (yv[nt][j] - mu[j]) * var[j] * lnw + lnb;
                    OCAT[(size_t)(g0 + t) * DM + 512 + hc] = f2bf((yn + RSUM[t] * q0[nt][j]) * q2[nt][j]); } }
        }
        RW_SYNC();
    }
}
#undef CONVL
#undef RW_LOAD
#undef RW_SYNC
__device__ __forceinline__ void rwkv_pass_b(const Params& p, LAS unsigned char* lds, int half) {
    const int tid = tid_fresh(), wave = tid >> 6, lane = tid & 63, fr = lane & 15, fq = lane >> 4;
    LAS float* Sb = (LAS float*)lds; LAS float* Pb = Sb + 2 * 64 * 68;
    float* RS = (float*)(p.ws + OFF_RS);
    const int NC = half ? 64 : 4, nchains = half ? 32 : 512;
    const int mt = wave >> 1, nt0 = (wave & 1) * 2;
    const int rrow = tid >> 3, rcol = (tid & 7) * 8;
    for (int chain = blockIdx.x; chain < nchains; chain += gridDim.x) {
        const int seqh = chain >> 4, h = (chain >> 1) & 7, dir = chain & 1;
        const size_t sidx = (size_t)((seqh * 2 + dir) * 8 + h) * 4096;
        float* E0 = RS + (size_t)(chain * NC) * 8192;
        f32x4 Sr[2];
#pragma unroll
        for (int q = 0; q < 2; ++q)
#pragma unroll
            for (int r = 0; r < 4; ++r) Sr[q][r] = half ? p.in[I_SR][sidx + (16 * mt + 4 * fq + r) * 64 + 16 * (nt0 + q) + fr] : 0.f;
        f32x4 Ln[2], pn0, pn1;
        pn0 = *(const f32x4*)(E0 + 4096 + rrow * 64 + rcol); pn1 = *(const f32x4*)(E0 + 4096 + rrow * 64 + rcol + 4);
#pragma unroll
        for (int q = 0; q < 2; ++q)
#pragma unroll
            for (int r = 0; r < 4; ++r) Ln[q][r] = E0[(16 * mt + 4 * fq + r) * 64 + 16 * (nt0 + q) + fr];
#pragma unroll
        for (int q = 0; q < 2; ++q)
#pragma unroll
            for (int r = 0; r < 4; ++r) Sb[(16 * mt + 4 * fq + r) * 68 + 16 * (nt0 + q) + fr] = Sr[q][r];
        *(LAS f32x4*)(Pb + rrow * 68 + rcol) = pn0; *(LAS f32x4*)(Pb + rrow * 68 + rcol + 4) = pn1;
        __syncthreads();
        for (int cp = 0; cp < NC; ++cp) {
            float* E = E0 + (size_t)cp * 8192;
            const LAS float* Sc = Sb + (cp & 1) * (64 * 68); const LAS float* Pc = Pb + (cp & 1) * (64 * 68);
            LAS float* Sn = Sb + ((cp + 1) & 1) * (64 * 68); LAS float* Pn = Pb + ((cp + 1) & 1) * (64 * 68);
            f32x4 acc[2] = {Ln[0], Ln[1]};
            const bool more = cp + 1 < NC;
            if (more) { const float* En = E + 8192;
                pn0 = *(const f32x4*)(En + 4096 + rrow * 64 + rcol); pn1 = *(const f32x4*)(En + 4096 + rrow * 64 + rcol + 4);
#pragma unroll
                for (int q = 0; q < 2; ++q)
#pragma unroll
                    for (int r = 0; r < 4; ++r) Ln[q][r] = En[(16 * mt + 4 * fq + r) * 64 + 16 * (nt0 + q) + fr]; }
            { const f32x4 s0 = *(const LAS f32x4*)(Sc + rrow * 68 + rcol), s1 = *(const LAS f32x4*)(Sc + rrow * 68 + rcol + 4);
              *(f32x4*)(E + rrow * 64 + rcol) = s0; *(f32x4*)(E + rrow * 64 + rcol + 4) = s1; }
#pragma unroll
            for (int kk = 0; kk < 16; ++kk) { const float av = Sc[(16 * mt + fr) * 68 + 4 * kk + fq];
                acc[0] = __builtin_amdgcn_mfma_f32_16x16x4f32(av, Pc[(4 * kk + fq) * 68 + 16 * nt0 + fr], acc[0], 0, 0, 0);
                acc[1] = __builtin_amdgcn_mfma_f32_16x16x4f32(av, Pc[(4 * kk + fq) * 68 + 16 * (nt0 + 1) + fr], acc[1], 0, 0, 0); }
            Sr[0] = acc[0]; Sr[1] = acc[1];
            if (more) {
#pragma unroll
                for (int q = 0; q < 2; ++q)
#pragma unroll
                    for (int r = 0; r < 4; ++r) Sn[(16 * mt + 4 * fq + r) * 68 + 16 * (nt0 + q) + fr] = Sr[q][r];
                *(LAS f32x4*)(Pn + rrow * 68 + rcol) = pn0; *(LAS f32x4*)(Pn + rrow * 68 + rcol + 4) = pn1; }
            __syncthreads();
        }
        if (!half) {
#pragma unroll
            for (int q = 0; q < 2; ++q)
#pragma unroll
                for (int r = 0; r < 4; ++r) p.out[20971520 + sidx + (16 * mt + 4 * fq + r) * 64 + 16 * (nt0 + q) + fr] = Sr[q][r];
        }
    }
}
__device__ __forceinline__ float gelu_tanh(float x) { const float u = 0.7978845608f * (x + 0.044715f * x * x * x); return x - x / (1.0f + __expf(2.0f * u)); }
__device__ __forceinline__ void phase_ffn_act(const Params& p) {
    const bf16_t* G = (const bf16_t*)(p.ws + OFF_G); bf16_t* UPp = (bf16_t*)(p.ws + OFF_UP);
    const float* cw = p.in[I_FCONV]; const float* cb = p.in[I_FCB];
    const int gt = blockIdx.x * 512 + tid_fresh(), GT = gridDim.x * 512;
    const int nslot = GT / 352, cgp = gt % 352, tslot = gt / 352, c0 = cgp * 8;
    if (tslot >= nslot) return;
    unsigned wp[9][4]; float bias[8];
#pragma unroll
    for (int k = 0; k < 9; ++k)
#pragma unroll
        for (int e = 0; e < 4; ++e) wp[k][e] = pk2(cw[(size_t)k * DFF + c0 + 2 * e], cw[(size_t)k * DFF + c0 + 2 * e + 1]);
#pragma unroll
    for (int e = 0; e < 8; ++e) bias[e] = cb[c0 + e];
    for (int tok0 = tslot; tok0 < NTOK; tok0 += 3 * nslot) {
        bf16x8 gv[3][9], uv[3]; float msk[3][9]; bool live[3];
#pragma unroll
        for (int u = 0; u < 3; ++u) { const int tok = tok0 + u * nslot; live[u] = tok < NTOK; const int tk = live[u] ? tok : tslot;
            const bool ctx = tk < 8192; const int tl = (tk - 8192) & 4095, gr = tl >> 6, gc = tl & 63, pos = tk & 255;
            if (ctx) {
#pragma unroll
                for (int k = 0; k < 9; ++k) { msk[u][k] = 0.0f; gv[u][k] = (bf16x8){0, 0, 0, 0, 0, 0, 0, 0}; }
#pragma unroll
                for (int kw = 0; kw < 3; ++kw) { const bool v = pos + kw - 1 >= 0 && pos + kw - 1 <= 255;
                    msk[u][3 + kw] = v ? 1.0f : 0.0f; gv[u][3 + kw] = *(const bf16x8*)(G + (size_t)(v ? tk + kw - 1 : tk) * DFF + c0); }
            } else {
#pragma unroll
                for (int kh = 0; kh < 3; ++kh)
#pragma unroll
                    for (int kw = 0; kw < 3; ++kw) {
                        const bool v = gr + kh - 1 >= 0 && gr + kh - 1 <= 63 && gc + kw - 1 >= 0 && gc + kw - 1 <= 63;
                        msk[u][kh * 3 + kw] = v ? 1.0f : 0.0f;
                        gv[u][kh * 3 + kw] = *(const bf16x8*)(G + (size_t)(v ? tk + (kh - 1) * 64 + (kw - 1) : tk) * DFF + c0); }
            }
            uv[u] = *(const bf16x8*)(UPp + (size_t)tk * DFF + c0); }
#pragma unroll
        for (int u = 0; u < 3; ++u) { const int tok = tok0 + u * nslot;
            float acc[8];
#pragma unroll
            for (int e = 0; e < 8; ++e) acc[e] = bias[e];
#pragma unroll
            for (int k = 0; k < 9; ++k)
#pragma unroll
                for (int e = 0; e < 8; ++e) acc[e] += (((e & 1) ? __uint_as_float(wp[k][e >> 1] & 0xffff0000u) : __uint_as_float(wp[k][e >> 1] << 16)) * msk[u][k]) * bf2f((bf16_t)gv[u][k][e]);
            u32x4 o; o.x = pk2(gelu_tanh(acc[0]) * bf2f((bf16_t)uv[u][0]), gelu_tanh(acc[1]) * bf2f((bf16_t)uv[u][1])); o.y = pk2(gelu_tanh(acc[2]) * bf2f((bf16_t)uv[u][2]), gelu_tanh(acc[3]) * bf2f((bf16_t)uv[u][3]));
            o.z = pk2(gelu_tanh(acc[4]) * bf2f((bf16_t)uv[u][4]), gelu_tanh(acc[5]) * bf2f((bf16_t)uv[u][5])); o.w = pk2(gelu_tanh(acc[6]) * bf2f((bf16_t)uv[u][6]), gelu_tanh(acc[7]) * bf2f((bf16_t)uv[u][7]));
            if (live[u]) *(u32x4*)(UPp + (size_t)tok * DFF + c0) = o; }
    }
}

constexpr int LDS_ST = 155648 + 3072;
constexpr int LDS_BYTES = LDS_ST + 16;
__global__ void __launch_bounds__(512, 2) mega(Params p) {
    extern __shared__ __attribute__((aligned(16))) unsigned char shm[];
    LAS unsigned char* lds = (LAS unsigned char*)shm;
    cg::grid_group grid = cg::this_grid();
    const float* mod = (const float*)(p.ws + OFF_MOD);
    bf16_t* H = (bf16_t*)(p.ws + OFF_H);
    pg8::StaticOrder S;
    volatile LAS unsigned* st = (volatile LAS unsigned*)(lds + LDS_ST);
    if (threadIdx.x == 0) { st[0] = 0u; st[1] = 0u; }
    __syncthreads();
    const XcdBarrier xb = xcd_barrier_post((unsigned*)(p.ws + OFF_BAR), st);

#ifndef SK0
    phase0(p, lds);
#endif
    if (p.ws == nullptr) grid.sync();
    xcd_barrier(xb);
    phase_norm_mod(p, nullptr, p.in[I_NMIX], 0, 1024, H);
    xcd_barrier(xb);
    { pg8::Gemm g{H, (const bf16_t*)(p.ws + OFF_WINT), NTOK, PINP, 1024}; S.init(NTOK, PINP, gridDim.x, blockIdx.x);
      pg8::EpiU E{(bf16_t*)(p.ws + OFF_U)};
#ifndef SKG
      pg8::gemm_phase(lds, g, S, E);
#endif
    }
    late_transposes(p, lds, 1088 - 4 * (int)gridDim.x);
    xcd_barrier(xb);
    rwkv_ain_phase(p, lds);
    xcd_barrier(xb);
    for (int half = 0; half < 2; ++half) {
#ifndef SK1
        rwkv_wy<false>(p, lds, half);
#endif
#ifndef SK2
        hgrn_pass_a(p, lds, half);
#endif
        xcd_barrier(xb);
#ifndef SK3
        rwkv_pass_b(p, lds, half);
#endif
#ifndef SK4
        hgrn_pass_b(p, half);
#endif
        xcd_barrier(xb);
#ifndef SK5
        rwkv_wy<true>(p, lds, half);
#endif
#ifndef SK6
        hgrn_pass_c(p, lds, half);
#endif
        xcd_barrier(xb);
    }
    { pg8::Gemm g{H, (const bf16_t*)(p.ws + OFF_WOUTT), NTOK, 1024, 1024}; S.init(NTOK, 1024, gridDim.x, blockIdx.x);
      pg8::EpiRes<true> E{p.out, p.in[I_XP], p.in[I_XS], mod + 2048};
#ifndef SKG
      pg8::gemm_phase(lds, g, S, E);
#endif
    }
    xcd_barrier(xb);
    phase_norm_mod(p, p.out, p.in[I_NFFN], 3072, 4096, H);
    xcd_barrier(xb);
    { pg8::Gemm g{H, (const bf16_t*)(p.ws + OFF_WGUT), NTOK, 2 * DFF, 1024}; S.init(NTOK, 2 * DFF, gridDim.x, blockIdx.x);
      pg8::EpiGU E{(bf16_t*)(p.ws + OFF_G), (bf16_t*)(p.ws + OFF_UP)};
#ifndef SKG
      pg8::gemm_phase(lds, g, S, E);
#endif
    }
    xcd_barrier(xb);
#ifndef SK7
    phase_ffn_act(p);
#endif
    xcd_barrier(xb);
    { pg8::Gemm g{(const bf16_t*)(p.ws + OFF_UP), (const bf16_t*)(p.ws + OFF_WDT), NTOK, 1024, DFF}; S.init(NTOK, 1024, gridDim.x, blockIdx.x);
      pg8::EpiRes<false> E{p.out, p.out, nullptr, mod + 5120};
#ifndef SKG
      pg8::gemm_phase(lds, g, S, E);
#endif
    }
    xcd_barrier(xb);
    phase_final_norm(p);
}

extern "C" void kernel_launch(void* const* d_in, const int* in_sizes, int n_in, void* d_out, int out_size, void* d_ws, size_t ws_size, hipStream_t stream) {
    static int grid_blocks = 0;
    if (grid_blocks == 0) {
        if (n_in != 31 || ws_size < WS_END) { fprintf(stderr, "kernel_launch: unexpected n_in %d / ws %zu (need %zu)\n", n_in, ws_size, (size_t)WS_END); grid_blocks = -1; return; }
        int dev = 0, cus = 0, per_cu = 0;
        hipGetDevice(&dev);
        hipDeviceGetAttribute(&cus, hipDeviceAttributeMultiprocessorCount, dev);
        if (hipFuncSetAttribute((const void*)mega, hipFuncAttributeMaxDynamicSharedMemorySize, LDS_BYTES) != hipSuccess) { fprintf(stderr, "kernel_launch: hipFuncSetAttribute failed\n"); grid_blocks = -1; return; }
        if (hipOccupancyMaxActiveBlocksPerMultiprocessor(&per_cu, (const void*)mega, 512, LDS_BYTES) != hipSuccess || per_cu < 1) { fprintf(stderr, "kernel_launch: occupancy query gave %d\n", per_cu); per_cu = 1; }
        (void)hipGetLastError();
        grid_blocks = cus * per_cu;
        if (grid_blocks > 256) grid_blocks = 256;
    }
    if (grid_blocks < 0) return;
    if (hipMemsetAsync((char*)d_ws + OFF_BAR, 0, 16384, stream) != hipSuccess) { fprintf(stderr, "kernel_launch: memset failed\n"); return; }
    Params p{};
    for (int i = 0; i < 31; ++i) p.in[i] = (const float*)d_in[i];
    p.out = (float*)d_out; p.ws = (unsigned char*)d_ws;
    void* args[] = {&p};
    hipError_t e = hipLaunchCooperativeKernel((const void*)mega, dim3(grid_blocks), dim3(512), args, LDS_BYTES, stream);
    if (e != hipSuccess) fprintf(stderr, "cooperative launch failed: %s (grid %d)\n", hipGetErrorString(e), grid_blocks);
}
```

```cpp
#include <hip/hip_runtime.h>
#include <hip/hip_cooperative_groups.h>
#include <cstdio>
#include <cstdint>
namespace cg = cooperative_groups;

#define LAS __attribute__((address_space(3)))
typedef unsigned short bf16_t;
typedef short bf16x8 __attribute__((ext_vector_type(8)));
typedef float f32x4 __attribute__((ext_vector_type(4)));
typedef float f32x2 __attribute__((ext_vector_type(2)));
typedef unsigned u32x4 __attribute__((ext_vector_type(4)));
typedef unsigned u32x2 __attribute__((ext_vector_type(2)));

constexpr int NTOK = 16384, DM = 1024, PIN = 4288, PINP = 4352, DFF = 2816, PB = 1728;
constexpr int UW = PIN;
constexpr float DECAY_SCALE = 0.6065306597f;

constexpr size_t OFF_MOD = 0;
constexpr size_t OFF_LB = 73728;
constexpr size_t OFF_W2T = 77824;
constexpr size_t OFF_A2T = OFF_W2T + 65536;
constexpr size_t OFF_G2T = OFF_A2T + 32768;
constexpr size_t OFF_HD = OFF_G2T + 98304;
constexpr size_t OFF_WOUTT = 1048576;
constexpr size_t OFF_WGUT = OFF_WOUTT + 2097152;
constexpr size_t OFF_WDT = OFF_WGUT + 11534336;
constexpr size_t OFF_H = OFF_WDT + 5767168;
constexpr size_t OFF_U = OFF_H + 33554432;
constexpr size_t OFF_RS = OFF_U + 140509184;
constexpr size_t OFF_WINT = OFF_RS;
constexpr size_t OFF_G = OFF_U;
constexpr size_t OFF_UP = OFF_U + 92274688;
constexpr size_t OFF_BAR = OFF_RS + 67108864;
constexpr size_t OFF_AIN = OFF_BAR + 16384;
constexpr size_t WS_END = OFF_AIN + 6291456;

struct Params {
    const float* in[31];
    float* out;
    unsigned char* ws;
};
enum { I_XP = 0, I_XS, I_SH, I_SR, I_C, I_CCTX, I_ADAW, I_ADAB, I_NMIX, I_WIN, I_LB, I_HNW, I_RCONV, I_W0, I_W2, I_A0, I_A2, I_G2,
       I_KK, I_KA, I_RK, I_LNW, I_LNB, I_WOUT, I_NFFN, I_WG, I_WU, I_FCONV, I_FCB, I_WD, I_FNW };

__device__ __forceinline__ float bf2f(bf16_t b) { return __uint_as_float(((unsigned)b) << 16); }
__device__ __forceinline__ unsigned cvt_pk_bf16(float lo, float hi) { unsigned r; asm("v_cvt_pk_bf16_f32 %0, %1, %2" : "=v"(r) : "v"(lo), "v"(hi)); return r; }
__device__ __forceinline__ bf16_t f2bf(float f) { return (bf16_t)cvt_pk_bf16(f, f); }
__device__ __forceinline__ unsigned pk2(float lo, float hi) { return cvt_pk_bf16(lo, hi); }
__device__ __forceinline__ float sigmoidf_(float x) { return 1.0f / (1.0f + __expf(-x)); }
__device__ __forceinline__ float siluf_(float x) { return x * sigmoidf_(x); }
__device__ __forceinline__ float wave_sum(float v) {
#pragma unroll
    for (int o = 1; o < 64; o <<= 1) v += __shfl_xor(v, o);
    return v;
}
__device__ __forceinline__ float quad_sum(float v) {
    v += __int_as_float(__builtin_amdgcn_update_dpp(0, __float_as_int(v), 0xB1, 0xF, 0xF, true));
    v += __int_as_float(__builtin_amdgcn_update_dpp(0, __float_as_int(v), 0x4E, 0xF, 0xF, true));
    return v;
}
__device__ __forceinline__ int tid_fresh() { int t = threadIdx.x; asm volatile("" : "+v"(t)); return t; }
__device__ __forceinline__ int bid_fresh() { int t = blockIdx.x; asm volatile("" : "+s"(t)); return t; }
__device__ __forceinline__ int mod_row(int tok) { return tok < 8192 ? 0 : 1 + ((tok - 8192) >> 12); }
__device__ __forceinline__ const float* x_row(const Params& p, int tok) { return tok < 8192 ? p.in[I_XP] + (size_t)tok * DM : p.in[I_XS] + (size_t)(tok - 8192) * DM; }

__device__ __forceinline__ f32x4 mma_ll(const LAS bf16_t* A, int lda, const LAS bf16_t* Bt, int ldb, int ksteps, f32x4 acc, int fr, int fq) {
    for (int kk = 0; kk < ksteps; ++kk) {
        bf16x8 a = *(const LAS bf16x8*)(A + fr * lda + kk * 32 + fq * 8);
        bf16x8 b = *(const LAS bf16x8*)(Bt + fr * ldb + kk * 32 + fq * 8);
        acc = __builtin_amdgcn_mfma_f32_16x16x32_bf16(a, b, acc, 0, 0, 0);
    }
    return acc;
}
__device__ __forceinline__ f32x4 mma_lg(const LAS bf16_t* A, int lda, const bf16_t* Bt, int ldb, int ksteps, f32x4 acc, int fr, int fq) {
    for (int kk = 0; kk < ksteps; ++kk) {
        bf16x8 a = *(const LAS bf16x8*)(A + fr * lda + kk * 32 + fq * 8);
        bf16x8 b = *(const bf16x8*)(Bt + fr * ldb + kk * 32 + fq * 8);
        acc = __builtin_amdgcn_mfma_f32_16x16x32_bf16(a, b, acc, 0, 0, 0);
    }
    return acc;
}


#define XB_TMO      128
#define XB_XCNT(j)  (256  + 64 * (j))
#define XB_XSUB(j)  (1280 + 64 * (j))
#define XB_XGEN(j)  (2304 + 64 * (j))
#define XB_TOP      3328
#define XB_TOPGEN   3392
#define XCD_BAR_WORDS 3456
#define XB_SPIN_CAP (1u << 18)
__device__ __forceinline__ unsigned xb_ld(unsigned* p)              { return __hip_atomic_load(p, __ATOMIC_RELAXED, __HIP_MEMORY_SCOPE_AGENT); }
__device__ __forceinline__ unsigned xb_add(unsigned* p, unsigned v) { return __hip_atomic_fetch_add(p, v, __ATOMIC_RELAXED, __HIP_MEMORY_SCOPE_AGENT); }
__device__ __forceinline__ unsigned xb_xcc_id() { return (unsigned)__builtin_amdgcn_s_getreg((3 << 11) | 20) & 0xFu; }
#define XB_SPIN(cond, bar) do { unsigned _sp = 0; while (cond) { __builtin_amdgcn_s_sleep(1); \
    if ((++_sp & 255u) == 0u) { if (xb_ld(&(bar)[XB_TMO])) break; if (_sp > XB_SPIN_CAP) { atomicAdd(&(bar)[XB_TMO], 1u); break; } } } } while (0)
struct XcdBarrier { unsigned* bar; unsigned x; volatile LAS unsigned* st; };
__device__ __forceinline__ XcdBarrier xcd_barrier_post(unsigned* bar, volatile LAS unsigned* st) {
    XcdBarrier b; b.bar = bar; b.x = xb_xcc_id(); b.st = st;
    if (threadIdx.x == 0) (void)xb_add(&bar[XB_XCNT(b.x)], 1u);
    return b;
}
__device__ __forceinline__ void xcd_barrier_complete(unsigned* bar, unsigned x, unsigned& nloc, unsigned& nx) {
    const unsigned G = gridDim.x * gridDim.y * gridDim.z;
    unsigned sum, cnt, mine, sp = 0u;
    for (;;) {
        sum = 0u; cnt = 0u; mine = 0u;
#pragma unroll
        for (unsigned j = 0; j < 16; ++j) { const unsigned c = xb_ld(&bar[XB_XCNT(j)]); sum += c; cnt += (c > 0u) ? 1u : 0u; mine = (j == x) ? c : mine; }
        if (sum == G) break;
        __builtin_amdgcn_s_sleep(1);
        if ((++sp & 255u) == 0u) { if (xb_ld(&bar[XB_TMO])) break; if (sp > XB_SPIN_CAP) { atomicAdd(&bar[XB_TMO], 1u); break; } }
    }
    nloc = mine > 0u ? mine : 1u; nx = cnt > 0u ? cnt : 1u;
}
__device__ __forceinline__ void xcd_barrier(const XcdBarrier& b) {
    asm volatile("s_waitcnt vmcnt(0)" ::: "memory");
    __syncthreads();
    if (threadIdx.x == 0) {
        unsigned* bar = b.bar;
        __builtin_amdgcn_s_waitcnt(0);
        unsigned nloc = b.st[0], nx = b.st[1];
        if (nloc == 0u) { xcd_barrier_complete(bar, b.x, nloc, nx); b.st[0] = nloc; b.st[1] = nx; }
        const unsigned old = xb_add(&bar[XB_XSUB(b.x)], 1u);
        const unsigned gen = old / nloc;
        if (old + 1u == (gen + 1u) * nloc) {
            __builtin_amdgcn_fence(__ATOMIC_RELEASE, "agent");
            asm volatile("s_waitcnt vmcnt(0)" ::: "memory");
            const unsigned og = xb_add(&bar[XB_TOP], 1u);
            const unsigned tg = og / nx;
            if (og + 1u == (tg + 1u) * nx) xb_add(&bar[XB_TOPGEN], 1u);
            else XB_SPIN(xb_ld(&bar[XB_TOPGEN]) == tg, bar);
            __builtin_amdgcn_fence(__ATOMIC_ACQUIRE, "agent");
            xb_add(&bar[XB_XGEN(b.x)], 1u);
            asm volatile("s_waitcnt vmcnt(0)" ::: "memory");
        } else {
            XB_SPIN(xb_ld(&bar[XB_XGEN(b.x)]) == gen, bar);
            __builtin_amdgcn_fence(__ATOMIC_ACQUIRE, "agent");
            asm volatile("s_waitcnt vmcnt(0)" ::: "memory");
        }
    }
    __syncthreads();
}

namespace pg8 {
constexpr int BM = 256, BK = 64, HALF = 128, HTB = HALF * BK * 2, STAGE_BYTES = 8 * HTB, NXCD = 8, WGM = 8;
__device__ __forceinline__ int lds_byte(int r, int c) { const int st = (r >> 4) * 2 + (c >> 5), rr = r & 15, cc = c & 31, ob = rr * 64 + cc * 2; return st * 1024 + (ob ^ (((ob >> 9) & 1) << 5)); }
__device__ __forceinline__ void stage_rc(int b, int& R, int& C) { const int st = b / 1024, sb = b % 1024, swz = sb ^ (((sb >> 9) & 1) << 5); R = (st >> 1) * 16 + swz / 64; C = (st & 1) * 32 + (swz % 64) / 2; }
__device__ __forceinline__ int perm32(int rho) { const int n = rho >> 4, i = rho & 15; return 8 * (i >> 2) + 4 * n + (i & 3); }
struct Unit { int pm, pn; };
struct Gemm { const bf16_t* A; const bf16_t* Bt; int M, N, K; };
struct StaticOrder {
    int nM, nN, nwg, G, c;
    __device__ void init(int M, int N, int G_, int c_) { nM = M / BM; nN = N / BM; nwg = nM * nN; G = G_; c = c_; }
    __device__ bool next(int i, Unit& u) const {
        const long L = (long)i * G + c; if (L >= nwg) return false;
        int wgid = (int)L; { const int q = nwg / NXCD, r = nwg % NXCD, xcd = wgid % NXCD, off = wgid / NXCD; wgid = (xcd < r ? xcd * (q + 1) : r * (q + 1) + (xcd - r) * q) + off; }
        const int nig = WGM * nN, gid = wgid / nig, fm = gid * WGM, gsz = (nM - fm) < WGM ? (nM - fm) : WGM;
        u.pm = fm + ((wgid % nig) % gsz); u.pn = (wgid % nig) / gsz; return true;
    }
};

struct EpiU {
    static constexpr bool PERM = true;
    bf16_t* O;
    __device__ __forceinline__ void operator()(const f32x4 (&acc)[2][2][4][2], const Unit& u, int wr, int wc, int fr, int fq) const {
        const int row0 = u.pm * BM + wr * 64 + fr, col0 = u.pn * BM + wc * 32 + 8 * fq;
#pragma unroll
        for (int ai = 0; ai < 2; ++ai)
#pragma unroll
            for (int m = 0; m < 4; ++m) { bf16_t* rowp = O + (size_t)(row0 + ai * HALF + m * 16) * UW + col0;
#pragma unroll
                for (int bj = 0; bj < 2; ++bj) { const f32x4 v0 = acc[ai][bj][m][0], v1 = acc[ai][bj][m][1];
                    u32x4 w; w.x = cvt_pk_bf16(v0[0], v0[1]); w.y = cvt_pk_bf16(v0[2], v0[3]); w.z = cvt_pk_bf16(v1[0], v1[1]); w.w = cvt_pk_bf16(v1[2], v1[3]);
                    if (col0 + bj * HALF < PIN) *(u32x4*)(rowp + bj * HALF) = w; } }
    }
};
struct EpiGU {
    static constexpr bool PERM = true;
    bf16_t* G; bf16_t* UPp;
    __device__ __forceinline__ void operator()(const f32x4 (&acc)[2][2][4][2], const Unit& u, int wr, int wc, int fr, int fq) const {
        int colt = u.pn * BM; bf16_t* base = G; if (colt >= DFF) { colt -= DFF; base = UPp; }
        const int row0 = u.pm * BM + wr * 64 + fr, col0 = colt + wc * 32 + 8 * fq;
#pragma unroll
        for (int ai = 0; ai < 2; ++ai)
#pragma unroll
            for (int m = 0; m < 4; ++m) { bf16_t* rowp = base + (size_t)(row0 + ai * HALF + m * 16) * DFF + col0;
#pragma unroll
                for (int bj = 0; bj < 2; ++bj) { const f32x4 v0 = acc[ai][bj][m][0], v1 = acc[ai][bj][m][1];
                    u32x4 w; w.x = cvt_pk_bf16(v0[0], v0[1]); w.y = cvt_pk_bf16(v0[2], v0[3]); w.z = cvt_pk_bf16(v1[0], v1[1]); w.w = cvt_pk_bf16(v1[2], v1[3]);
                    *(u32x4*)(rowp + bj * HALF) = w; } }
    }
};
template <bool XIN> struct EpiRes {
    static constexpr bool PERM = false;
    float* OUT; const float* RESp; const float* xs; const float* gate;
    __device__ __forceinline__ void operator()(const f32x4 (&acc)[2][2][4][2], const Unit& u, int wr, int wc, int fr, int fq) const {
        const int row0 = u.pm * BM + wr * 64 + fr, col0 = u.pn * BM + wc * 32 + 4 * fq;
        const float* gr = gate + (size_t)mod_row(u.pm * BM) * 6144 + col0;
        f32x4 gv[2][2];
#pragma unroll
        for (int bj = 0; bj < 2; ++bj)
#pragma unroll
            for (int n = 0; n < 2; ++n) gv[bj][n] = *(const f32x4*)(gr + bj * HALF + n * 16);
        f32x4 rv[2][2][2];
        auto rowptr = [&](int g) -> const float* { const int r = row0 + (g >> 2) * HALF + (g & 3) * 16;
            const float* res = RESp + (size_t)r * DM; if (XIN) { if (r >= 8192) res = xs + (size_t)(r - 8192) * DM; } return res + col0; };
        { const float* rp = rowptr(0);
#pragma unroll
          for (int bj = 0; bj < 2; ++bj)
#pragma unroll
              for (int n = 0; n < 2; ++n) rv[0][bj][n] = *(const f32x4*)(rp + bj * HALF + n * 16); }
#pragma unroll
        for (int g = 0; g < 8; ++g) { const int ai = g >> 2, m = g & 3;
            if (g + 1 < 8) { const float* rp = rowptr(g + 1);
#pragma unroll
                for (int bj = 0; bj < 2; ++bj)
#pragma unroll
                    for (int n = 0; n < 2; ++n) rv[(g + 1) & 1][bj][n] = *(const f32x4*)(rp + bj * HALF + n * 16); }
            float* orow = OUT + (size_t)(row0 + ai * HALF + m * 16) * DM + col0;
#pragma unroll
            for (int bj = 0; bj < 2; ++bj)
#pragma unroll
                for (int n = 0; n < 2; ++n) *(f32x4*)(orow + bj * HALF + n * 16) = rv[g & 1][bj][n] + gv[bj][n] * acc[ai][bj][m][n]; }
    }
};

template <class Epi>
__device__ __forceinline__ void gemm_phase(LAS unsigned char* lds, const Gemm g, const StaticOrder& S, const Epi& E) {
    const int tid = tid_fresh(), wid = __builtin_amdgcn_readfirstlane(tid >> 6), lane = tid & 63, wr = wid >> 2, wc = wid & 3, fr = lane & 15, fq = lane >> 4;
    const int K = g.K, nt = K / BK;
    unsigned voffA[2], voffB[2];
#pragma unroll
    for (int i = 0; i < 2; ++i) { int R, C; stage_rc(tid * 16 + i * 8192, R, C); const int Rb = Epi::PERM ? ((R & ~31) + perm32(R & 31)) : R;
        voffA[i] = (unsigned)(R * K + C) * 2u; voffB[i] = (unsigned)(Rb * K + C) * 2u; }
    const size_t kstep = (size_t)(BK * 2);
    const size_t hstep = (size_t)HALF * K * 2;
    const size_t tstep = 2 * hstep;
    const unsigned ldsw = (unsigned)wid * 1024u;
    const int aoff = lds_byte(wr * 64 + fr, fq * 8), boff = lds_byte(wc * 32 + fr, fq * 8);
#define PG8_SA(b, h) (((b) * 2 + (h)) * HTB)
#define PG8_SB(b, h) ((4 + (b) * 2 + (h)) * HTB)
#define PG8_STAGE(bufoff, gbase, voff) do { _Pragma("unroll") for (int _i = 0; _i < 2; ++_i) \
        __builtin_amdgcn_global_load_lds((const unsigned*)((const char*)(gbase) + (voff)[_i]), (LAS unsigned*)(lds + (bufoff) + ldsw + _i * 8192), 16, 0, 0); } while (0)
#define PG8_LDA(dst, b, h) do { _Pragma("unroll") for (int m = 0; m < 4; ++m) _Pragma("unroll") for (int k = 0; k < 2; ++k) dst[m][k] = *(const LAS bf16x8*)(lds + PG8_SA(b, h) + aoff + m * 2048 + k * 1024); } while (0)
#define PG8_LDB(dst, b, h) do { _Pragma("unroll") for (int n = 0; n < 2; ++n) _Pragma("unroll") for (int k = 0; k < 2; ++k) dst[n][k] = *(const LAS bf16x8*)(lds + PG8_SB(b, h) + boff + n * 2048 + k * 1024); } while (0)
#define PG8_MMA(ai, bj, At, Bt) do { __builtin_amdgcn_s_setprio(1); _Pragma("unroll") for (int m = 0; m < 4; ++m) _Pragma("unroll") for (int n = 0; n < 2; ++n) _Pragma("unroll") for (int k = 0; k < 2; ++k) \
        acc[ai][bj][m][n] = __builtin_amdgcn_mfma_f32_16x16x32_bf16(Bt[n][k], At[m][k], acc[ai][bj][m][n], 0, 0, 0); __builtin_amdgcn_s_setprio(0); } while (0)
#define PG8_WAIT_V(n) asm volatile("s_waitcnt vmcnt(" #n ")" ::: "memory")
#define PG8_WAIT_L(n) asm volatile("s_waitcnt lgkmcnt(" #n ")" ::: "memory")
#define PG8_BAR __builtin_amdgcn_s_barrier()
#define PG8_SCHED __builtin_amdgcn_sched_barrier(0)
    Unit cur, nxt; int ui = 0;
    if (!S.next(0, cur)) return;
    f32x4 acc[2][2][4][2];
#pragma unroll
    for (int a = 0; a < 2; ++a)
#pragma unroll
        for (int b = 0; b < 2; ++b)
#pragma unroll
            for (int m = 0; m < 4; ++m)
#pragma unroll
                for (int n = 0; n < 2; ++n) acc[a][b][m][n] = (f32x4){0.f, 0.f, 0.f, 0.f};
    bf16x8 At[4][2], B0[2][2], B1[2][2];
    const char* cA = (const char*)g.A + (size_t)cur.pm * tstep; const char* cB = (const char*)g.Bt + (size_t)cur.pn * tstep;
    PG8_STAGE(PG8_SB(0, 0), cB, voffB); PG8_STAGE(PG8_SA(0, 0), cA, voffA); PG8_STAGE(PG8_SB(0, 1), cB + hstep, voffB); PG8_STAGE(PG8_SA(0, 1), cA + hstep, voffA);
    if (wr == 1) PG8_BAR;
    PG8_WAIT_V(4); PG8_BAR;
    PG8_STAGE(PG8_SB(1, 0), cB + kstep, voffB); PG8_STAGE(PG8_SA(1, 0), cA + kstep, voffA); PG8_STAGE(PG8_SB(1, 1), cB + hstep + kstep, voffB);
    PG8_WAIT_V(6); PG8_BAR;
    for (;;) {
        const bool has_next = S.next(ui + 1, nxt);
        const char* nA = has_next ? (const char*)g.A + (size_t)nxt.pm * tstep : cA; const char* nB = has_next ? (const char*)g.Bt + (size_t)nxt.pn * tstep : cB;
        for (int t = 0; t < nt; t += 2) {
            const bool last = (t == nt - 2);
            const char* a1 = cA + (size_t)(t + 1) * kstep;
            const char* a2 = last ? nA : cA + (size_t)(t + 2) * kstep; const char* b2 = last ? nB : cB + (size_t)(t + 2) * kstep;
            const char* a3 = a2 + kstep; const char* b3 = b2 + kstep;
            PG8_LDB(B0, 0, 0); PG8_SCHED; PG8_LDA(At, 0, 0); PG8_STAGE(PG8_SA(1, 1), a1 + hstep, voffA);
            PG8_WAIT_L(8); PG8_BAR; PG8_WAIT_L(0); PG8_MMA(0, 0, At, B0); PG8_BAR; PG8_SCHED;
            PG8_LDB(B1, 0, 1); PG8_STAGE(PG8_SB(0, 0), b2, voffB);
            PG8_BAR; PG8_WAIT_L(0); PG8_MMA(0, 1, At, B1); PG8_BAR;
            PG8_LDA(At, 0, 1); PG8_STAGE(PG8_SA(0, 0), a2, voffA);
            PG8_BAR; PG8_WAIT_L(0); PG8_MMA(1, 0, At, B0); PG8_BAR; PG8_SCHED;
            PG8_STAGE(PG8_SB(0, 1), b2 + hstep, voffB);
            PG8_WAIT_V(6); PG8_BAR; PG8_MMA(1, 1, At, B1); PG8_BAR;
            PG8_LDB(B0, 1, 0); PG8_SCHED; PG8_LDA(At, 1, 0); PG8_STAGE(PG8_SA(0, 1), a2 + hstep, voffA);
            PG8_WAIT_L(8); PG8_BAR; PG8_WAIT_L(0); PG8_MMA(0, 0, At, B0); PG8_BAR; PG8_SCHED;
            PG8_LDB(B1, 1, 1); PG8_STAGE(PG8_SB(1, 0), b3, voffB);
            PG8_BAR; PG8_WAIT_L(0); PG8_MMA(0, 1, At, B1); PG8_BAR;
            PG8_LDA(At, 1, 1); PG8_STAGE(PG8_SA(1, 0), a3, voffA);
            PG8_BAR; PG8_WAIT_L(0); PG8_MMA(1, 0, At, B0); PG8_BAR; PG8_SCHED;
            PG8_STAGE(PG8_SB(1, 1), b3 + hstep, voffB);
            PG8_WAIT_V(6); PG8_BAR; PG8_MMA(1, 1, At, B1); PG8_BAR;
        }
        E(acc, cur, wr, wc, fr, fq);
        if (!has_next) break;
#pragma unroll
        for (int a = 0; a < 2; ++a)
#pragma unroll
            for (int b = 0; b < 2; ++b)
#pragma unroll
                for (int m = 0; m < 4; ++m)
#pragma unroll
                    for (int n = 0; n < 2; ++n) acc[a][b][m][n] = (f32x4){0.f, 0.f, 0.f, 0.f};
        cur = nxt; cA = nA; cB = nB; ++ui;
    }
    PG8_WAIT_V(0);
    if (wr == 0) PG8_BAR;
    PG8_BAR;
#undef PG8_SA
#undef PG8_SB
#undef PG8_STAGE
#undef PG8_LDA
#undef PG8_LDB
#undef PG8_MMA
#undef PG8_WAIT_V
#undef PG8_WAIT_L
#undef PG8_BAR
#undef PG8_SCHED
}
}

__device__ __forceinline__ void transpose_tile(const float* W, int K, int N, bf16_t* WT, int row_off, int tile, LAS float* scr) {
    const int nb = N / 64, kb = tile / nb, nbi = tile % nb, k0 = kb * 64, n0 = nbi * 64, tid = tid_fresh();
#pragma unroll
    for (int i = 0; i < 8; ++i) { const int kk = (tid >> 6) + 8 * i, nn = tid & 63; scr[kk * 65 + nn] = W[(size_t)(k0 + kk) * N + n0 + nn]; }
    __syncthreads();
    { const int n = tid >> 3, kc = (tid & 7) * 8; const LAS float* s = scr + kc * 65 + n;
      u32x4 o; o.x = pk2(s[0], s[65]); o.y = pk2(s[2 * 65], s[3 * 65]); o.z = pk2(s[4 * 65], s[5 * 65]); o.w = pk2(s[6 * 65], s[7 * 65]);
      *(u32x4*)(WT + (size_t)(row_off + n0 + n) * K + k0 + kc) = o; }
    __syncthreads();
}
__device__ __forceinline__ void late_transposes(const Params& p, LAS unsigned char* lds, int first) {
    LAS float* scr = (LAS float*)lds;
    const int bid = blockIdx.x, G = gridDim.x;
    if (bid < first) return;
    bf16_t* WoutT = (bf16_t*)(p.ws + OFF_WOUTT); bf16_t* WguT = (bf16_t*)(p.ws + OFF_WGUT); bf16_t* WdT = (bf16_t*)(p.ws + OFF_WDT);
    constexpr int T_OUT = 16 * 16, T_G = 16 * 44, T_D = 44 * 16, T_ALL = T_OUT + 2 * T_G + T_D;
    for (int it = bid - first; it < T_ALL; it += G - first) {
        int r = it;
        if (r < T_OUT) { transpose_tile(p.in[I_WOUT], 1024, 1024, WoutT, 0, r, scr); continue; } r -= T_OUT;
        if (r < T_G) { transpose_tile(p.in[I_WG], 1024, DFF, WguT, 0, r, scr); continue; } r -= T_G;
        if (r < T_G) { transpose_tile(p.in[I_WU], 1024, DFF, WguT, DFF, r, scr); continue; } r -= T_G;
        transpose_tile(p.in[I_WD], DFF, 1024, WdT, 0, r, scr);
    }
}
__device__ __forceinline__ void phase0(const Params& p, LAS unsigned char* lds) {
    LAS float* scr = (LAS float*)lds;
    const int tid = tid_fresh(), bid = blockIdx.x, G = gridDim.x;
    bf16_t* WinT = (bf16_t*)(p.ws + OFF_WINT);
    if (bid < 96) {
        const int w = tid >> 6, lane = tid & 63, n = bid * 64 + lane;
        const float* aw = p.in[I_ADAW]; const float* cc = p.in[I_CCTX]; const float* c = p.in[I_C];
        LAS float* sc = scr + 2048;
        for (int i = tid; i < 3072; i += 512) sc[i] = siluf_(i < 1024 ? cc[i] : c[i - 1024]);
        __syncthreads();
        float a0 = 0.f, a1 = 0.f, a2 = 0.f;
        for (int k0 = w * 128; k0 < w * 128 + 128; k0 += 16) { float wv[16];
#pragma unroll
            for (int u = 0; u < 16; ++u) wv[u] = aw[(size_t)(k0 + u) * 6144 + n];
#pragma unroll
            for (int u = 0; u < 16; ++u) { a0 += sc[k0 + u] * wv[u]; a1 += sc[1024 + k0 + u] * wv[u]; a2 += sc[2048 + k0 + u] * wv[u]; } }
        scr[(w * 3 + 0) * 64 + lane] = a0; scr[(w * 3 + 1) * 64 + lane] = a1; scr[(w * 3 + 2) * 64 + lane] = a2;
        __syncthreads();
        if (tid < 192) { const int r = tid >> 6, l = tid & 63; float sacc = p.in[I_ADAB][bid * 64 + l];
#pragma unroll
            for (int ww = 0; ww < 8; ++ww) sacc += scr[(ww * 3 + r) * 64 + l];
            ((float*)(p.ws + OFF_MOD))[r * 6144 + bid * 64 + l] = sacc; }
        __syncthreads();
    }
    constexpr int T_IN = 16 * 67;
    for (int it = (bid + 160) % G; it < T_IN; it += G) transpose_tile(p.in[I_WIN], 1024, PIN, WinT, 0, it, scr);
    const int gt = bid * 512 + tid, GT = G * 512;
    for (int i = gt; i < 64 * 1024 / 8; i += GT) *(u32x4*)(WinT + (size_t)PIN * 1024 + (size_t)i * 8) = (u32x4){0u, 0u, 0u, 0u};
    for (int i = gt; i < 1024; i += GT) { const float l0 = p.in[I_LB][i], l1 = p.in[I_LB][1024 + i]; ((float*)(p.ws + OFF_LB))[i] = 1.0f / (1.0f + __expf(l1 - l0)); }
    { bf16_t* w2T = (bf16_t*)(p.ws + OFF_W2T); bf16_t* a2T = (bf16_t*)(p.ws + OFF_A2T); bf16_t* g2T = (bf16_t*)(p.ws + OFF_G2T);
      for (int i = gt; i < 2 * 512 * 32; i += GT) { const int d = i >> 14, ch = (i >> 5) & 511, l = i & 31; w2T[i] = f2bf(p.in[I_W2][(d * 32 + l) * 512 + ch]); }
      for (int i = gt; i < 512 * 32; i += GT) { const int ch = i >> 5, l = i & 31; a2T[i] = f2bf(p.in[I_A2][l * 512 + ch]); }
      for (int i = gt; i < 512 * 96; i += GT) { const int ch = i / 96, l = i % 96; g2T[i] = f2bf(p.in[I_G2][l * 512 + ch]); } }
}

__device__ __forceinline__ void phase_norm_mod(const Params& p, const float* src  , const float* nw, int shift_off, int scale_off, bf16_t* OUT) {
    const int tidf = tid_fresh(), lane = tidf & 63, gw = blockIdx.x * 8 + (tidf >> 6), NW = gridDim.x * 8;
    const float* mod = (const float*)(p.ws + OFF_MOD);
    for (int r0 = gw; r0 < NTOK; r0 += 4 * NW) {
        f32x4 v[4][4]; float s[4] = {0.f, 0.f, 0.f, 0.f};
#pragma unroll
        for (int u = 0; u < 4; ++u) { const int r = r0 + u * NW; const float* xr = src ? src + (size_t)r * DM : x_row(p, r);
#pragma unroll
            for (int j = 0; j < 4; ++j) v[u][j] = *(const f32x4*)(xr + 4 * lane + 256 * j); }
#pragma unroll
        for (int u = 0; u < 4; ++u) {
#pragma unroll
            for (int j = 0; j < 4; ++j) s[u] += v[u][j].x * v[u][j].x + v[u][j].y * v[u][j].y + v[u][j].z * v[u][j].z + v[u][j].w * v[u][j].w; }
#pragma unroll
        for (int u = 0; u < 4; ++u) { const int r = r0 + u * NW; const float* mr = mod + (size_t)mod_row(r) * 6144;
            const float rs = rsqrtf(wave_sum(s[u]) * (1.0f / DM) + 1e-6f);
#pragma unroll
            for (int j = 0; j < 4; ++j) { const int c = 4 * lane + 256 * j;
                const f32x4 w4 = *(const f32x4*)(nw + c), sc = *(const f32x4*)(mr + scale_off + c), sh = *(const f32x4*)(mr + shift_off + c);
                const f32x4 h = v[u][j] * rs * w4 * (sc + 1.0f) + sh;
                u32x2 o; o.x = pk2(h.x, h.y); o.y = pk2(h.z, h.w);
                *(u32x2*)(OUT + (size_t)r * DM + c) = o; } }
    }
}
__device__ __forceinline__ void phase_final_norm(const Params& p) {
    const int tidf = tid_fresh(), lane = tidf & 63, gw = blockIdx.x * 8 + (tidf >> 6), NW = gridDim.x * 8;
    const float* nw = p.in[I_FNW];
    for (int r0 = gw; r0 < NTOK; r0 += 4 * NW) {
        f32x4 v[4][4]; float s[4] = {0.f, 0.f, 0.f, 0.f};
#pragma unroll
        for (int u = 0; u < 4; ++u) { float* xr = p.out + (size_t)(r0 + u * NW) * DM;
#pragma unroll
            for (int j = 0; j < 4; ++j) v[u][j] = *(const f32x4*)(xr + 4 * lane + 256 * j); }
#pragma unroll
        for (int u = 0; u < 4; ++u) {
#pragma unroll
            for (int j = 0; j < 4; ++j) s[u] += v[u][j].x * v[u][j].x + v[u][j].y * v[u][j].y + v[u][j].z * v[u][j].z + v[u][j].w * v[u][j].w; }
#pragma unroll
        for (int u = 0; u < 4; ++u) { float* xr = p.out + (size_t)(r0 + u * NW) * DM;
            const float rs = rsqrtf(wave_sum(s[u]) * (1.0f / DM) + 1e-6f);
#pragma unroll
            for (int j = 0; j < 4; ++j) { const int c = 4 * lane + 256 * j; *(f32x4*)(xr + c) = v[u][j] * rs * *(const f32x4*)(nw + c); } }
    }
}

constexpr int H_LDT = 72, H_LDQ = 136, H_LDP = 72, H_LDO = 132;
template <int NQ>
__device__ __forceinline__ void hgrn_stage_load(const bf16_t* U, int g0, int h, int dir, int tid, u32x4 (&pf)[NQ / 8]) {
#pragma unroll
    for (int it = 0; it < NQ / 8; ++it) { const int idx = tid + it * 512, tl = idx / NQ, q = idx - tl * NQ;
        const int col = q < 16 ? 512 + h * 128 + q * 8 : (q < 32 ? 1024 + dir * 512 + h * 128 + (q - 16) * 8 : h * 128 + (q - 32) * 8);
        pf[it] = *(const u32x4*)(U + (size_t)(g0 + tl) * UW + col); }
}
template <int NQ>
__device__ __forceinline__ void hgrn_stage_store(LAS bf16_t* STG, int tid, const u32x4 (&pf)[NQ / 8]) {
#pragma unroll
    for (int it = 0; it < NQ / 8; ++it) { const int idx = tid + it * 512, tl = idx / NQ, q = idx - tl * NQ; *(LAS u32x4*)(STG + tl * 384 + q * 8) = pf[it]; }
}
__device__ __forceinline__ void lds_barrier() { asm volatile("s_waitcnt lgkmcnt(0)" ::: "memory"); __builtin_amdgcn_s_barrier(); asm volatile("" ::: "memory"); }
__device__ __forceinline__ void hgrn_load16(const LAS bf16_t* STG, int dir, int tg, int ch, float lbv, float (&lf)[16], float (&kv)[16], float (&vv)[16], float (&qs)[16], bool need_q) {
#pragma unroll
    for (int j = 0; j < 16; ++j) { const int s = tg * 16 + j, tl = dir ? 63 - s : s; const LAS bf16_t* ur = STG + tl * 384;
        const float z = bf2f(ur[128 + ch]); const float f = lbv + (1.0f - lbv) * sigmoidf_(z);
        lf[j] = __logf(f); kv[j] = 1.0f - f; vv[j] = bf2f(ur[ch]);
        qs[j] = need_q ? siluf_(bf2f(ur[256 + ch])) : 0.f; }
#pragma unroll
    for (int j = 1; j < 16; ++j) lf[j] += lf[j - 1];
}
__device__ __forceinline__ void hgrn_pass_a(const Params& p, LAS unsigned char* lds, int half) {
    const int tid = tid_fresh(), wave = tid >> 6, lane = tid & 63, fr = lane & 15, fq = lane >> 4;
    const bf16_t* U = (const bf16_t*)(p.ws + OFF_U); const float* lb = (const float*)(p.ws + OFF_LB);
    float* Lbuf = p.out; float* Dbuf = (float*)(p.ws + OFF_HD);
    LAS bf16_t* KlT = (LAS bf16_t*)lds; LAS bf16_t* VT = KlT + 128 * H_LDT; LAS float* tot = (LAS float*)(VT + 128 * H_LDT);
    const int NC = half ? 64 : 4, ncl = half ? 6 : 2;
    u32x4 pf[4];
    float lbn = 0.f;
    if ((int)blockIdx.x < 1024) { const int t0 = blockIdx.x; hgrn_stage_load<32>(U, half * 8192 + (t0 >> 3) * 64, (t0 >> 1) & 3, t0 & 1, tid, pf); lbn = lb[(t0 & 1) * 512 + ((t0 >> 1) & 3) * 128 + (tid & 127)]; }
    for (int task = blockIdx.x; task < 1024; task += gridDim.x) {
        const int cidx = task >> 3, h = (task >> 1) & 3, dir = task & 1;
        const int seqh = cidx >> ncl, c = cidx & (NC - 1), cp = dir ? NC - 1 - c : c;
        const int entry = ((seqh * 4 + h) * 2 + dir) * NC + cp;
        const int ch = tid & 127, tg = tid >> 7;
        float lf[16], kv[16], vv[16], qs[16];
        hgrn_stage_store<32>((LAS bf16_t*)(lds + 40960), tid, pf);
        const float lbv = lbn;
        lds_barrier();
        hgrn_load16((const LAS bf16_t*)(lds + 40960), dir, tg, ch, lbv, lf, kv, vv, qs, false);
        tot[tg * 128 + ch] = lf[15];
        lds_barrier();
        { const int nx = task + gridDim.x;
          if (nx < 1024) { hgrn_stage_load<32>(U, half * 8192 + (nx >> 3) * 64, (nx >> 1) & 3, nx & 1, tid, pf); lbn = lb[(nx & 1) * 512 + ((nx >> 1) & 3) * 128 + ch]; } }
        float off = 0.f, blast = 0.f;
#pragma unroll
        for (int t = 0; t < 4; ++t) { const float tv = tot[t * 128 + ch]; blast += tv; if (t < tg) off += tv; }
        unsigned kw[8], vw[8];
#pragma unroll
        for (int j = 0; j < 16; j += 2) { const float b0 = off + lf[j], b1 = off + lf[j + 1];
            kw[j >> 1] = pk2(kv[j] * __expf(blast - b0), kv[j + 1] * __expf(blast - b1)); vw[j >> 1] = pk2(vv[j], vv[j + 1]); }
        *(LAS u32x4*)(KlT + ch * H_LDT + tg * 16) = (u32x4){kw[0], kw[1], kw[2], kw[3]}; *(LAS u32x4*)(KlT + ch * H_LDT + tg * 16 + 8) = (u32x4){kw[4], kw[5], kw[6], kw[7]};
        *(LAS u32x4*)(VT + ch * H_LDT + tg * 16) = (u32x4){vw[0], vw[1], vw[2], vw[3]}; *(LAS u32x4*)(VT + ch * H_LDT + tg * 16 + 8) = (u32x4){vw[4], vw[5], vw[6], vw[7]};
        if (tg == 0) Dbuf[entry * 128 + ch] = __expf(blast);
        lds_barrier();
        float* Lo = Lbuf + (size_t)entry * 16384;
        for (int nt = 0; nt < 8; ++nt) {
            f32x4 acc = mma_ll(KlT + 16 * wave * H_LDT, H_LDT, VT + 16 * nt * H_LDT, H_LDT, 2, (f32x4){0.f, 0.f, 0.f, 0.f}, fr, fq);
#pragma unroll
            for (int j = 0; j < 4; ++j) Lo[(16 * wave + fq * 4 + j) * 128 + nt * 16 + fr] = acc[j];
        }
        lds_barrier();
    }
}
__device__ __forceinline__ void hgrn_pass_b(const Params& p, int half) {
    float* Lbuf = p.out; const float* Dbuf = (const float*)(p.ws + OFF_HD);
    const int NC = half ? 64 : 4, nchains = half ? 16 : 256, nb = NC / 4;
    const int G = gridDim.x, vb = half ? (blockIdx.x + G / 2) % G : blockIdx.x;
    const int gt = vb * 512 + tid_fresh(), GT = G * 512, nitems = nchains * 4096;
    if (gt >= nitems) return;
    f32x4 L[4], Ln[4]; float Dv[4], Dn[4];
#define HB_LOAD(LL, DD, ITEM, BATCH) do { const int ch_ = (ITEM) >> 12, e4_ = (ITEM) & 4095, d_ = e4_ >> 5; \
        _Pragma("unroll") for (int u = 0; u < 4; ++u) { const int en_ = ch_ * NC + (BATCH) * 4 + u; LL[u] = *(const f32x4*)(Lbuf + (size_t)en_ * 16384 + e4_ * 4); DD[u] = Dbuf[en_ * 128 + d_]; } } while (0)
    HB_LOAD(L, Dv, gt, 0);
    for (int item = gt; item < nitems; item += GT) {
        const int chain = item >> 12, e4 = item & 4095;
        const int seqh = chain >> 3, h = (chain >> 1) & 3, dir = chain & 1;
        f32x4 S = (f32x4){0.f, 0.f, 0.f, 0.f};
        if (half) S = *(const f32x4*)(p.in[I_SH] + (size_t)((seqh * 2 + dir) * 4 + h) * 16384 + e4 * 4);
        for (int bt = 0; bt < nb; ++bt) {
            const bool more_b = bt + 1 < nb, more_i = item + GT < nitems;
            if (more_b) HB_LOAD(Ln, Dn, item, bt + 1); else if (more_i) HB_LOAD(Ln, Dn, item + GT, 0);
#pragma unroll
            for (int u = 0; u < 4; ++u) { const int entry = chain * NC + bt * 4 + u; *(f32x4*)(Lbuf + (size_t)entry * 16384 + e4 * 4) = S; S = S * Dv[u] + L[u]; }
#pragma unroll
            for (int u = 0; u < 4; ++u) { L[u] = Ln[u]; Dv[u] = Dn[u]; }
        }
        if (!half) *(f32x4*)(p.out + 16777216 + (size_t)((seqh * 2 + dir) * 4 + h) * 16384 + e4 * 4) = S;
    }
#undef HB_LOAD
}
__device__ __forceinline__ void hgrn_pass_c(const Params& p, LAS unsigned char* lds, int half) {
    const int tid = tid_fresh(), wave = tid >> 6, lane = tid & 63, fr = lane & 15, fq = lane >> 4;
    const bf16_t* U = (const bf16_t*)(p.ws + OFF_U); const float* lb = (const float*)(p.ws + OFF_LB);
    const float* Lbuf = p.out; bf16_t* OCAT = (bf16_t*)(p.ws + OFF_H);
    LAS bf16_t* Qi = (LAS bf16_t*)lds; LAS bf16_t* Qm = Qi + 64 * H_LDQ; LAS bf16_t* Km = Qm + 64 * H_LDQ; LAS bf16_t* VT = Km + 64 * H_LDQ;
    LAS float* Osum = (LAS float*)(VT + 128 * H_LDT); LAS bf16_t* SsT = (LAS bf16_t*)(Osum + 64 * H_LDO); LAS bf16_t* Ps = SsT + 128 * H_LDQ; LAS float* tot = (LAS float*)(lds + 153600);
    const int NC = half ? 64 : 4, ncl = half ? 6 : 2;
    u32x4 pf[6];
    float lbn = 0.f;
    if ((int)blockIdx.x < 512) { const int t0 = blockIdx.x; hgrn_stage_load<48>(U, half * 8192 + (t0 >> 2) * 64, t0 & 3, 0, tid, pf); lbn = lb[(t0 & 3) * 128 + (tid & 127)]; }
    bf16_t gpre[16]; float nwp[2] = {0.f, 0.f};
    for (int task = blockIdx.x; task < 512; task += gridDim.x) {
        const int cidx = task >> 2, h = task & 3;
        const int seqh = cidx >> ncl, c = cidx & (NC - 1), g0 = half * 8192 + cidx * 64;
        for (int dir = 0; dir < 2; ++dir) {
            const int cp = dir ? NC - 1 - c : c, entry = ((seqh * 4 + h) * 2 + dir) * NC + cp;
            const int ch = tid & 127, tg = tid >> 7;
            {
                float lf[16], kv[16], vv[16], qs[16];
                hgrn_stage_store<48>((LAS bf16_t*)SsT, tid, pf);
                const float lbv = lbn;
                lds_barrier();
                hgrn_load16((const LAS bf16_t*)SsT, dir, tg, ch, lbv, lf, kv, vv, qs, true);
                tot[tg * 128 + ch] = lf[15];
                lds_barrier();
                float off = 0.f;
#pragma unroll
                for (int t = 0; t < 4; ++t) { const float tv = tot[t * 128 + ch]; if (t < tg) off += tv; }
                const float bmid = tot[ch] + tot[128 + ch];
                unsigned vw[8];
#pragma unroll
                for (int j = 0; j < 16; ++j) { const int s = tg * 16 + j; const float bs = off + lf[j];
                    Qi[s * H_LDQ + ch] = f2bf(qs[j] * __expf(bs)); Qm[s * H_LDQ + ch] = f2bf(qs[j] * __expf(bs - bmid)); Km[s * H_LDQ + ch] = f2bf(kv[j] * __expf(bmid - bs)); }
#pragma unroll
                for (int j = 0; j < 16; j += 2) vw[j >> 1] = pk2(vv[j], vv[j + 1]);
                *(LAS u32x4*)(VT + ch * H_LDT + tg * 16) = (u32x4){vw[0], vw[1], vw[2], vw[3]}; *(LAS u32x4*)(VT + ch * H_LDT + tg * 16 + 8) = (u32x4){vw[4], vw[5], vw[6], vw[7]};
            }
            { const float* Sp = Lbuf + (size_t)entry * 16384;
              for (int idx = tid; idx < 4096; idx += 512) { const int d = idx >> 5, e4 = (idx & 31) * 4; const f32x4 sv = *(const f32x4*)(Sp + d * 128 + e4);
                  SsT[(e4 + 0) * H_LDQ + d] = f2bf(sv.x); SsT[(e4 + 1) * H_LDQ + d] = f2bf(sv.y); SsT[(e4 + 2) * H_LDQ + d] = f2bf(sv.z); SsT[(e4 + 3) * H_LDQ + d] = f2bf(sv.w); } }
            {
                const int nt_ = dir ? task + (int)gridDim.x : task, nd_ = dir ^ 1;
                if (nt_ < 512) { hgrn_stage_load<48>(U, half * 8192 + (nt_ >> 2) * 64, nt_ & 3, nd_, tid, pf); lbn = lb[nd_ * 512 + (nt_ & 3) * 128 + (tid & 127)]; }
                if (dir) { const float* nw = p.in[I_HNW] + h * 128; nwp[0] = nw[lane]; nwp[1] = nw[64 + lane];
#pragma unroll
                    for (int q = 0; q < 8; ++q) { const bf16_t* ur = U + (size_t)(g0 + wave * 8 + q) * UW + 2048 + h * 128; gpre[2 * q] = ur[lane]; gpre[2 * q + 1] = ur[64 + lane]; } } }
            lds_barrier();
            for (int tt = 0; tt < 2; ++tt) { const int tile = wave * 2 + tt, mt = tile >> 2, nt = tile & 3;
                f32x4 acc = mma_ll(Qm + 16 * mt * H_LDQ, H_LDQ, Km + 16 * nt * H_LDQ, H_LDQ, 4, (f32x4){0.f, 0.f, 0.f, 0.f}, fr, fq);
#pragma unroll
                for (int j = 0; j < 4; ++j) { const int t = 16 * mt + fq * 4 + j, s = 16 * nt + fr; Ps[t * H_LDP + s] = f2bf(s <= t ? acc[j] : 0.f); } }
            lds_barrier();
            { const int mt = wave >> 1;
              for (int q = 0; q < 4; ++q) { const int nt = (wave & 1) * 4 + q;
                  f32x4 acc = mma_ll(Qi + 16 * mt * H_LDQ, H_LDQ, SsT + 16 * nt * H_LDQ, H_LDQ, 4, (f32x4){0.f, 0.f, 0.f, 0.f}, fr, fq);
                  acc = mma_ll(Ps + 16 * mt * H_LDP, H_LDP, VT + 16 * nt * H_LDT, H_LDT, 2, acc, fr, fq);
#pragma unroll
                  for (int j = 0; j < 4; ++j) { const int s = 16 * mt + fq * 4 + j, tl = dir ? 63 - s : s, e = 16 * nt + fr;
                      if (dir == 0) Osum[tl * H_LDO + e] = acc[j]; else Osum[tl * H_LDO + e] += acc[j]; } } }
            lds_barrier();
        }
#pragma unroll
        for (int q = 0; q < 8; ++q) { const int tl = wave * 8 + q, tok = g0 + tl;
            const float v0 = Osum[tl * H_LDO + lane], v1 = Osum[tl * H_LDO + 64 + lane];
            const float rs = rsqrtf(wave_sum(v0 * v0 + v1 * v1) * (1.0f / 128.0f) + 1e-6f);
            OCAT[(size_t)tok * DM + h * 128 + lane] = f2bf(v0 * rs * nwp[0] * siluf_(bf2f(gpre[2 * q])));
            OCAT[(size_t)tok * DM + h * 128 + 64 + lane] = f2bf(v1 * rs * nwp[1] * siluf_(bf2f(gpre[2 * q + 1]))); }
        lds_barrier();
    }
}

__device__ __forceinline__ float conv3(const bf16_t* U, const float* cw, int tok, int pos, int T, int colb) {
    const bf16_t* up = U + (size_t)tok * UW + 2560 + colb;
    float v = cw[PB + colb] * bf2f(up[0]);
    if (pos > 0) v += cw[colb] * bf2f(*(up - UW));
    if (pos < T - 1) v += cw[2 * PB + colb] * bf2f(up[UW]);
    return v;
}
constexpr int W_DIR = 77824;
constexpr int W_KAP = 0, W_KT = 8192, W_BT = 16384, W_XT = 8192  , W_A3 = 24576  , W_VT = 40960,
              W_NABK = 49152, W_AKK = 57344, W_CUM = 49152  , W_ADG = 65536, W_RB = 69632;
constexpr int W_KTT = 24576, W_BTT = 32768, W_RT = 24576, W_ARK = 32768;
constexpr int W_SMALL = 155648;
constexpr int W_AIN = W_DIR;
__device__ __forceinline__ int swz(int row, int col) { return row * 64 + ((((col >> 3) ^ row) & 7) << 3) + (col & 7); }
__device__ __forceinline__ f32x4 mma_sw(const LAS bf16_t* A, int a0, const LAS bf16_t* B, int b0, f32x4 acc, int fr, int fq) {
    const int ar = a0 + fr, br = b0 + fr;
#pragma unroll
    for (int kk = 0; kk < 2; ++kk) {
        const bf16x8 a = *(const LAS bf16x8*)(A + ar * 64 + ((((kk * 4 + fq) ^ ar) & 7) << 3));
        const bf16x8 b = *(const LAS bf16x8*)(B + br * 64 + ((((kk * 4 + fq) ^ br) & 7) << 3));
        acc = __builtin_amdgcn_mfma_f32_16x16x32_bf16(a, b, acc, 0, 0, 0); }
    return acc;
}
__device__ __forceinline__ f32x4 mma_sw_reg(const LAS bf16_t* A, int a0, const bf16x8 (&bfrag)[2], f32x4 acc, int fr, int fq) {
    const int ar = a0 + fr;
#pragma unroll
    for (int kk = 0; kk < 2; ++kk) {
        const bf16x8 a = *(const LAS bf16x8*)(A + ar * 64 + ((((kk * 4 + fq) ^ ar) & 7) << 3));
        acc = __builtin_amdgcn_mfma_f32_16x16x32_bf16(a, bfrag[kk], acc, 0, 0, 0); }
    return acc;
}
__device__ __forceinline__ void rwkv_ain_phase(const Params& p, LAS unsigned char* lds) {
    const bf16_t* U = (const bf16_t*)(p.ws + OFF_U); const float* cw = p.in[I_RCONV]; bf16_t* AinG = (bf16_t*)(p.ws + OFF_AIN);
    LAS bf16_t* UBs = (LAS bf16_t*)lds; LAS float* CWs = (LAS float*)(lds + 25344);
    for (int cg = blockIdx.x; cg < 256; cg += gridDim.x) {
        const int tid = tid_fresh(), half = cg >> 7, T = half ? 4096 : 256, g0 = cg * 64, t0 = (g0 - half * 8192) & (T - 1);
#pragma unroll
        for (int it = 0; it < 4; ++it) { const int idx = tid + it * 512;
            if (idx < 66 * 24) { const int rr = idx / 24, q = idx - rr * 24, pos = t0 - 1 + rr;
                u32x4 val = (u32x4){0u, 0u, 0u, 0u};
                if (pos >= 0 && pos < T) val = *(const u32x4*)(U + (size_t)(g0 - 1 + rr) * UW + 2560 + 1536 + q * 8);
                *(LAS u32x4*)(UBs + rr * 192 + q * 8) = val; } }
        for (int idx = tid; idx < 3 * 192; idx += 512) { const int tap = idx / 192, cc = idx - tap * 192; CWs[idx] = cw[tap * PB + 1536 + cc]; }
        __syncthreads();
#pragma unroll 4
        for (int it = 0; it < 24; ++it) { const int idx = tid + it * 512, t = idx / 192, l = idx - t * 192;
            float v = CWs[l] * bf2f(UBs[t * 192 + l]) + CWs[192 + l] * bf2f(UBs[(t + 1) * 192 + l]) + CWs[384 + l] * bf2f(UBs[(t + 2) * 192 + l]);
            if (l < 64) v = 1.0f - 2.0f / (1.0f + __expf(2.0f * v)); else if (l >= 96) v = sigmoidf_(v);
            AinG[(size_t)cg * 12288 + idx] = f2bf(v); }
        __syncthreads();
    }
}
template <bool PC>
__device__ __forceinline__ void rwkv_wy(const Params& p, LAS unsigned char* lds, int half) {
    const bf16_t* U = (const bf16_t*)(p.ws + OFF_U); const float* cw = p.in[I_RCONV];
    float* RS = (float*)(p.ws + OFF_RS); bf16_t* OCAT = (bf16_t*)(p.ws + OFF_H);
    const bf16_t* w2T = (const bf16_t*)(p.ws + OFF_W2T); const bf16_t* a2T = (const bf16_t*)(p.ws + OFF_A2T); const bf16_t* g2T = (const bf16_t*)(p.ws + OFF_G2T);
    LAS bf16_t* Ain = (LAS bf16_t*)(lds + W_AIN);
    LAS float* WcC = (LAS float*)(lds + W_SMALL); LAS float* RSUM = WcC + 128; LAS float* SEG = WcC + 192;
    const int NC = half ? 64 : 4, ncl = half ? 6 : 2, T = half ? 4096 : 256;
    const f32x4 z4 = (f32x4){0.f, 0.f, 0.f, 0.f};
    u32x4 pu[4], pa[3]; float pw[2];
#define RW_LOAD(TASK_) do { const int tid_ = tid_fresh(), cx_ = (TASK_) >> 3, hh_ = (TASK_) & 7, g0_ = half * 8192 + cx_ * 64, t0_ = (cx_ * 64) & (T - 1); \
        const bf16_t* AinG_ = (const bf16_t*)(p.ws + OFF_AIN) + (size_t)(half * 128 + cx_) * 12288; \
        _Pragma("unroll") for (int it = 0; it < 4; ++it) { const int idx = tid_ + it * 512, rr = idx / 24, q = idx - rr * 24, pos = t0_ - 1 + rr; \
            pu[it] = (u32x4){0u, 0u, 0u, 0u}; \
            if (idx < 66 * 24 && pos >= 0 && pos < T) pu[it] = *(const u32x4*)(U + (size_t)(g0_ - 1 + rr) * UW + 2560 + (q >> 3) * 512 + hh_ * 64 + (q & 7) * 8); } \
        _Pragma("unroll") for (int it = 0; it < 3; ++it) { const int idx = tid_ + it * 512, t = idx / 24, q = idx - t * 24; pa[it] = *(const u32x4*)(AinG_ + t * 192 + q * 8); } \
        _Pragma("unroll") for (int it = 0; it < 2; ++it) { const int idx = tid_ + it * 512, tap = idx / 192, cc = idx - tap * 192; \
            pw[it] = idx < 3 * 192 ? cw[tap * PB + (cc >> 6) * 512 + hh_ * 64 + (cc & 63)] : 0.f; } } while (0)
#define RW_SYNC() do { if (PC) __syncthreads(); else lds_barrier(); } while (0)
    bf16x8 lf0[4], lf1[4]; int hcur = -1;
    if (!PC && (int)blockIdx.x < 1024) RW_LOAD((int)blockIdx.x);
    for (int task = blockIdx.x; task < 1024; task += gridDim.x) {
        const int tid = tid_fresh(), wave = tid >> 6, lane = tid & 63, fr = lane & 15, fq = lane >> 4;
        const int mt = wave & 3, hf = wave >> 2;
        const int dir = wave >> 2, wd = wave & 3;
        LAS unsigned char* D = lds + dir * W_DIR;
        const int cidx = task >> 3, h = task & 7, seqh = cidx >> ncl, c = cidx & (NC - 1), g0 = half * 8192 + cidx * 64, t0 = (cidx * 64) & (T - 1);
        if (h != hcur) { hcur = h;
#pragma unroll
            for (int nt = 0; nt < 4; ++nt) { const size_t rowb = (size_t)(h * 64 + nt * 16 + fr) * 32 + fq * 8;
                if (hf == 0) { lf0[nt] = *(const bf16x8*)(w2T + rowb); lf1[nt] = *(const bf16x8*)(w2T + (size_t)512 * 32 + rowb); }
                else { lf0[nt] = *(const bf16x8*)(a2T + rowb); lf1[nt] = lf0[nt]; } } }
        if (PC) RW_LOAD(task);
        {   LAS bf16_t* UBs = (LAS bf16_t*)lds; LAS float* CWs = (LAS float*)(lds + 50688);
#pragma unroll
            for (int it = 0; it < 4; ++it) { const int idx = tid + it * 512, rr = idx / 24, q = idx - rr * 24; if (idx < 66 * 24) *(LAS u32x4*)(UBs + rr * 384 + q * 8) = pu[it]; }
#pragma unroll
            for (int it = 0; it < 3; ++it) { const int idx = tid + it * 512, t = idx / 24, q = idx - t * 24; *(LAS u32x4*)(Ain + t * 200 + q * 8) = pa[it]; }
#pragma unroll
            for (int it = 0; it < 2; ++it) { const int idx = tid + it * 512, tap = idx / 192, cc = idx - tap * 192; if (idx < 3 * 192) CWs[tap * 384 + cc] = pw[it]; }
        }
        RW_SYNC();
#define CONVL(t_, c_) (((const LAS float*)(lds + 50688))[c_] * bf2f(((const LAS bf16_t*)lds)[(t_) * 384 + (c_)]) + ((const LAS float*)(lds + 50688))[384 + (c_)] * bf2f(((const LAS bf16_t*)lds)[((t_) + 1) * 384 + (c_)]) + ((const LAS float*)(lds + 50688))[768 + (c_)] * bf2f(((const LAS bf16_t*)lds)[((t_) + 2) * 384 + (c_)]))
        float q0[4][4], q1[4][4], q2[4][4];
        float lwf[4][4], lwb[4][4];
        if (hf == 0) {
            const float* w0 = p.in[I_W0];
#pragma unroll
            for (int nt = 0; nt < 4; ++nt) { const int chl = nt * 16 + fr, hc = h * 64 + chl;
                const f32x4 af = __builtin_amdgcn_mfma_f32_16x16x32_bf16(*(const LAS bf16x8*)(Ain + (16 * mt + fr) * 200 + fq * 8), lf0[nt], z4, 0, 0, 0);
                const f32x4 ab = __builtin_amdgcn_mfma_f32_16x16x32_bf16(*(const LAS bf16x8*)(Ain + (16 * mt + fr) * 200 + 32 + fq * 8), lf1[nt], z4, 0, 0, 0);
                f32x4 ag = z4; if (PC) ag = mma_lg(Ain + 16 * mt * 200 + 96, 200, g2T + (size_t)(hc - fr) * 96, 96, 3, z4, fr, fq);
                const float w0f = w0[hc], w0b = w0[512 + hc];
#pragma unroll
                for (int j = 0; j < 4; ++j) { const int t = 16 * mt + fq * 4 + j;
                    lwf[nt][j] = -DECAY_SCALE * sigmoidf_(w0f + af[j]); lwb[nt][j] = -DECAY_SCALE * sigmoidf_(w0b + ab[j]);
                    q0[nt][j] = CONVL(t, 128 + chl);
                    q1[nt][j] = PC ? CONVL(t, chl) : 0.f; q2[nt][j] = ag[j]; } }
        } else {
            float ssq[4] = {0.f, 0.f, 0.f, 0.f};
#pragma unroll
            for (int nt = 0; nt < 4; ++nt) { const int chl = nt * 16 + fr, hc = h * 64 + chl;
                const f32x4 aa = __builtin_amdgcn_mfma_f32_16x16x32_bf16(*(const LAS bf16x8*)(Ain + (16 * mt + fr) * 200 + 64 + fq * 8), lf0[nt], z4, 0, 0, 0);
                const float a0 = p.in[I_A0][hc], k_k = p.in[I_KK][hc], k_a = p.in[I_KA][hc];
#pragma unroll
                for (int j = 0; j < 4; ++j) { const int t = 16 * mt + fq * 4 + j;
                    const float kraw = CONVL(t, 64 + chl), a = sigmoidf_(a0 + aa[j]);
                    q2[nt][j] = kraw * (1.0f + (a - 1.0f) * k_a); q0[nt][j] = kraw * k_k; q1[nt][j] = a; ssq[j] += q0[nt][j] * q0[nt][j];
                    lwf[nt][j] = 0.f; lwb[nt][j] = 0.f; } }
#pragma unroll
            for (int j = 0; j < 4; ++j) { float sq = ssq[j]; sq += __shfl_xor(sq, 1); sq += __shfl_xor(sq, 2); sq += __shfl_xor(sq, 4); sq += __shfl_xor(sq, 8); ssq[j] = rsqrtf(sq + 1e-12f); }
#pragma unroll
            for (int nt = 0; nt < 4; ++nt)
#pragma unroll
                for (int j = 0; j < 4; ++j) { q0[nt][j] *= ssq[j]; q1[nt][j] *= q0[nt][j]; }
        }
        RW_SYNC();
        if (!PC) { const int nx = task + (int)gridDim.x; if (nx < 1024) RW_LOAD(nx); }
        if (hf == 0) {
#pragma unroll
            for (int nt = 0; nt < 4; ++nt)
#pragma unroll
                for (int j = 0; j < 4; ++j) { const int t = 16 * mt + fq * 4 + j, chl = nt * 16 + fr;
                    ((LAS float*)(lds + W_CUM))[t * 64 + chl] = lwf[nt][j]; ((LAS float*)(lds + W_DIR + W_CUM))[(63 - t) * 64 + chl] = lwb[nt][j];
                    if (PC) ((LAS float*)(lds + W_RB))[t * 64 + chl] = q1[nt][j] * p.in[I_RK][h * 64 + chl]; }
        }
        RW_SYNC();
        {
            const int chl = tid & 63, dd = (tid >> 6) & 1, sg = tid >> 7; LAS float* C = (LAS float*)(lds + dd * W_DIR + W_CUM);
            float cs[16];
#pragma unroll
            for (int u = 0; u < 16; ++u) { cs[u] = C[(sg * 16 + u) * 64 + chl]; if (u) cs[u] += cs[u - 1]; }
            SEG[(dd * 4 + sg) * 64 + chl] = cs[15];
            if (PC && hf == 1) {
                float part[4] = {0.f, 0.f, 0.f, 0.f};
#pragma unroll
                for (int nt = 0; nt < 4; ++nt)
#pragma unroll
                    for (int j = 0; j < 4; ++j) part[j] += ((LAS float*)(lds + W_RB))[(16 * mt + fq * 4 + j) * 64 + nt * 16 + fr] * q2[nt][j];
#pragma unroll
                for (int j = 0; j < 4; ++j) { float sq = part[j]; sq += __shfl_xor(sq, 1); sq += __shfl_xor(sq, 2); sq += __shfl_xor(sq, 4); sq += __shfl_xor(sq, 8); if (fr == 0) RSUM[16 * mt + fq * 4 + j] = sq; }
            }
            RW_SYNC();
            float off = 0.f;
#pragma unroll
            for (int g = 0; g < 4; ++g) if (g < sg) off += SEG[(dd * 4 + g) * 64 + chl];
#pragma unroll
            for (int u = 0; u < 16; ++u) C[(sg * 16 + u) * 64 + chl] = cs[u] + off;
            if (sg == 3) WcC[dd * 64 + chl] = __expf(cs[15] + off);
        }
        RW_SYNC();
#pragma unroll
        for (int dd = 0; dd < 2; ++dd) { LAS unsigned char* R = lds + dd * W_DIR; const LAS float* C = (const LAS float*)(R + W_CUM);
#pragma unroll
            for (int nt = 0; nt < 4; ++nt)
#pragma unroll
                for (int j = 0; j < 4; ++j) { const int t = 16 * mt + fq * 4 + j, chl = nt * 16 + fr, sp = dd ? 63 - t : t;
                    const float c1 = C[sp * 64 + chl];
                    if (hf == 0) {
                        ((LAS bf16_t*)(R + W_VT))[swz(chl, sp)] = f2bf(q0[nt][j]);
                        if (PC) ((LAS bf16_t*)(R + W_RT))[swz(sp, chl)] = f2bf(q1[nt][j] * __expf(c1));
                    } else {
                        const float c0 = sp ? C[(sp - 1) * 64 + chl] : 0.f, e1 = __expf(-c1);
                        ((LAS bf16_t*)(R + W_KAP))[swz(sp, chl)] = f2bf(q0[nt][j] * __expf(c0));
                        const bf16_t kt = f2bf(q2[nt][j] * e1), bt = f2bf(q1[nt][j] * e1);
                        ((LAS bf16_t*)(R + W_KT))[swz(sp, chl)] = kt; ((LAS bf16_t*)(R + W_BT))[swz(sp, chl)] = bt;
                        if (!PC) { ((LAS bf16_t*)(R + W_KTT))[swz(chl, sp)] = kt; ((LAS bf16_t*)(R + W_BTT))[swz(chl, sp)] = bt; }
                    } } }
        RW_SYNC();
        {   LAS bf16_t* KAP = (LAS bf16_t*)(D + W_KAP); LAS bf16_t* KT = (LAS bf16_t*)(D + W_KT); LAS bf16_t* BT = (LAS bf16_t*)(D + W_BT);
            LAS bf16_t* NABK = (LAS bf16_t*)(D + W_NABK); LAS bf16_t* AKK = (LAS bf16_t*)(D + W_AKK); LAS float* ADG = (LAS float*)(D + W_ADG);
            const int t = 16 * wd + fr;
#pragma unroll
            for (int nt = 0; nt < 4; ++nt) { const int s0 = 16 * nt + 4 * fq;
                const int aoff = t * 64 + ((((2 * nt + (fq >> 1)) ^ t) & 7) << 3) + (fq & 1) * 4;
                f32x4 akk = mma_sw(KT, 16 * nt, KAP, 16 * wd, z4, fr, fq), abk = mma_sw(BT, 16 * nt, KAP, 16 * wd, z4, fr, fq);
#pragma unroll
                for (int r = 0; r < 4; ++r) { const bool lo = s0 + r < t; akk[r] = lo ? akk[r] : 0.f; abk[r] = lo ? abk[r] : 0.f; }
                *(LAS u32x2*)(AKK + aoff) = (u32x2){pk2(akk[0], akk[1]), pk2(akk[2], akk[3])};
                if (nt == wd) { *(LAS f32x4*)(ADG + (wd * 16 + fr) * 16 + 4 * fq) = abk; *(LAS u32x2*)(NABK + aoff) = (u32x2){0u, 0u}; }
                else *(LAS u32x2*)(NABK + aoff) = (u32x2){pk2(-abk[0], -abk[1]), pk2(-abk[2], -abk[3])};
                if (PC) { LAS bf16_t* RT = (LAS bf16_t*)(D + W_RT);
                    f32x4 ark = mma_sw(KT, 16 * nt, RT, 16 * wd, z4, fr, fq), arb = mma_sw(BT, 16 * nt, RT, 16 * wd, z4, fr, fq);
#pragma unroll
                    for (int r = 0; r < 4; ++r) { const bool le = s0 + r <= t; ark[r] = le ? ark[r] : 0.f; lwf[nt][r] = le ? -arb[r] : 0.f; }
                    *(LAS u32x2*)((LAS bf16_t*)(D + W_ARK) + aoff) = (u32x2){pk2(ark[0], ark[1]), pk2(ark[2], ark[3])}; }
            } }
        RW_SYNC();
        {   LAS unsigned* X32 = (LAS unsigned*)(D + W_XT);
            if (PC) { for (int i = (tid & 255); i < 2048; i += 256) X32[i] = 0u;
                const int t = 16 * wd + fr;
#pragma unroll
                for (int nt = 0; nt < 4; ++nt)
                    *(LAS u32x2*)((LAS bf16_t*)(D + W_BT) + t * 64 + ((((2 * nt + (fq >> 1)) ^ t) & 7) << 3) + (fq & 1) * 4) = (u32x2){pk2(lwf[nt][0], lwf[nt][1]), pk2(lwf[nt][2], lwf[nt][3])};
            } else { for (int i = (tid & 255); i < 4096; i += 256) X32[i] = 0u; }
            if (wd == 0) { LAS float* ADG = (LAS float*)(D + W_ADG); const int bb = lane >> 4, cc = lane & 15;
                float tv[16];
#pragma unroll
                for (int tl = 0; tl < 16; ++tl) { float v = (tl == cc) ? 1.f : 0.f;
#pragma unroll
                    for (int sl = 0; sl < tl; ++sl) v -= ADG[(bb * 16 + tl) * 16 + sl] * tv[sl];
                    tv[tl] = v; }
                asm volatile("s_waitcnt lgkmcnt(0)" ::: "memory");
#pragma unroll
                for (int tl = 0; tl < 16; ++tl) ADG[(bb * 16 + tl) * 16 + cc] = tv[tl]; }
        }
        const int cp = dir ? NC - 1 - c : c, entry = ((seqh * 8 + h) * 2 + dir) * NC + cp;
        float* E = RS + (size_t)entry * 8192;
        bf16x8 zw[2];
        if (PC) {
#pragma unroll
            for (int kk = 0; kk < 2; ++kk) { const float* sp = E + (16 * wd + fr) * 64 + kk * 32 + fq * 8; const f32x4 x0 = *(const f32x4*)sp, x1 = *(const f32x4*)(sp + 4);
                u32x4 w; w.x = pk2(x0.x, x0.y); w.y = pk2(x0.z, x0.w); w.z = pk2(x1.x, x1.y); w.w = pk2(x1.z, x1.w); zw[kk] = __builtin_bit_cast(bf16x8, w); }
        }
        RW_SYNC();
        {   LAS bf16_t* KAP = (LAS bf16_t*)(D + W_KAP); LAS bf16_t* NABK = (LAS bf16_t*)(D + W_NABK); LAS bf16_t* AKK = (LAS bf16_t*)(D + W_AKK); LAS bf16_t* VT = (LAS bf16_t*)(D + W_VT);
            LAS bf16_t* XT = (LAS bf16_t*)(D + W_XT); LAS float* ADG = (LAS float*)(D + W_ADG); LAS float* RB = (LAS float*)(D + W_RB);
            for (int b = 0; b < 4; ++b) {
                if (PC) {
                    f32x4 acc = mma_sw_reg(KAP, 16 * b, zw, z4, fr, fq);
                    acc = mma_sw(AKK, 16 * b, VT, 16 * wd, acc, fr, fq);
                    acc = mma_sw(NABK, 16 * b, XT, 16 * wd, acc, fr, fq);
#pragma unroll
                    for (int r = 0; r < 4; ++r) RB[(fq * 4 + r) * 64 + 16 * wd + fr] = acc[r];
                } else {
                    f32x4 a0 = mma_sw(NABK, 16 * b, XT, 16 * wd, z4, fr, fq);
                    f32x4 a1 = mma_sw(AKK, 16 * b, VT, 16 * wd, z4, fr, fq);
                    a1 = mma_sw(NABK, 16 * b, XT, 64 + 16 * wd, a1, fr, fq);
#pragma unroll
                    for (int r = 0; r < 4; ++r) { RB[(fq * 4 + r) * 128 + 16 * wd + fr] = a0[r] + bf2f(KAP[swz(16 * b + 4 * fq + r, 16 * wd + fr)]); RB[(fq * 4 + r) * 128 + 64 + 16 * wd + fr] = a1[r]; }
                }
                asm volatile("s_waitcnt lgkmcnt(0)" ::: "memory");
                {
                    constexpr int RBW = PC ? 64 : 128;
#pragma unroll
                    for (int q = 0; q < (PC ? 1 : 2); ++q) { const int col0 = q * 64 + 16 * wd; f32x4 x = z4;
#pragma unroll
                        for (int kk = 0; kk < 4; ++kk) x = __builtin_amdgcn_mfma_f32_16x16x4f32(ADG[(16 * b + fr) * 16 + 4 * kk + fq], RB[(4 * kk + fq) * RBW + col0 + fr], x, 0, 0, 0);
                        const int col = col0 + fr;
                        *(LAS u32x2*)(XT + col * 64 + ((((2 * b + (fq >> 1)) ^ col) & 7) << 3) + (fq & 1) * 4) = (u32x2){pk2(x[0], x[1]), pk2(x[2], x[3])}; } }
                asm volatile("s_waitcnt lgkmcnt(0)" ::: "memory");
            }
            RW_SYNC();
            if (!PC) {
                LAS bf16_t* KTT = (LAS bf16_t*)(D + W_KTT); LAS bf16_t* BTT = (LAS bf16_t*)(D + W_BTT);
#pragma unroll
                for (int nt = 0; nt < 4; ++nt) { const float wc = WcC[dir * 64 + 16 * nt + fr];
                    const f32x4 qp = mma_sw(XT, 16 * wd, BTT, 16 * nt, z4, fr, fq);
                    const f32x4 l1 = mma_sw(VT, 16 * wd, KTT, 16 * nt, z4, fr, fq);
                    const f32x4 l2 = mma_sw(XT, 64 + 16 * wd, BTT, 16 * nt, z4, fr, fq);
#pragma unroll
                    for (int r = 0; r < 4; ++r) { const int m = 16 * wd + fq * 4 + r, jj = 16 * nt + fr;
                        E[4096 + m * 64 + jj] = ((m == jj ? 1.f : 0.f) - qp[r]) * wc; E[m * 64 + jj] = (l1[r] - l2[r]) * wc; } }
            } else {
                LAS bf16_t* RT = (LAS bf16_t*)(D + W_RT); LAS bf16_t* ARK = (LAS bf16_t*)(D + W_ARK); LAS bf16_t* NARB = (LAS bf16_t*)(D + W_BT);
                f32x4 y[4];
#pragma unroll
                for (int nt = 0; nt < 4; ++nt) { bf16x8 zf[2];
#pragma unroll
                    for (int kk = 0; kk < 2; ++kk) { const float* sp = E + (16 * nt + fr) * 64 + kk * 32 + fq * 8; const f32x4 x0 = *(const f32x4*)sp, x1 = *(const f32x4*)(sp + 4);
                        u32x4 w; w.x = pk2(x0.x, x0.y); w.y = pk2(x0.z, x0.w); w.z = pk2(x1.x, x1.y); w.w = pk2(x1.z, x1.w); zf[kk] = __builtin_bit_cast(bf16x8, w); }
                    y[nt] = mma_sw_reg(RT, 16 * wd, zf, z4, fr, fq);
                    y[nt] = mma_sw(ARK, 16 * wd, VT, 16 * nt, y[nt], fr, fq); y[nt] = mma_sw(NARB, 16 * wd, XT, 16 * nt, y[nt], fr, fq); }
                RW_SYNC();
                LAS float* Yd = (LAS float*)(D + W_NABK);
#pragma unroll
                for (int nt = 0; nt < 4; ++nt)
#pragma unroll
                    for (int r = 0; r < 4; ++r) { const int sp = 16 * wd + fq * 4 + r, t = dir ? 63 - sp : sp; Yd[t * 64 + 16 * nt + fr] = y[nt][r]; }
            }
        }
        RW_SYNC();
        if (PC && hf == 0) {
            const LAS float* Yf = (const LAS float*)(lds + W_NABK); const LAS float* Yb = (const LAS float*)(lds + W_DIR + W_NABK);
            float yv[4][4], mu[4] = {0.f, 0.f, 0.f, 0.f}, var[4] = {0.f, 0.f, 0.f, 0.f};
#pragma unroll
            for (int nt = 0; nt < 4; ++nt)
#pragma unroll
                for (int j = 0; j < 4; ++j) { const int t = 16 * mt + fq * 4 + j, chl = nt * 16 + fr; yv[nt][j] = Yf[t * 64 + chl] + Yb[t * 64 + chl]; mu[j] += yv[nt][j]; }
#pragma unroll
            for (int j = 0; j < 4; ++j) { float sq = mu[j]; sq += __shfl_xor(sq, 1); sq += __shfl_xor(sq, 2); sq += __shfl_xor(sq, 4); sq += __shfl_xor(sq, 8); mu[j] = sq * (1.0f / 64.0f); }
#pragma unroll
            for (int nt = 0; nt < 4; ++nt)
#pragma unroll
                for (int j = 0; j < 4; ++j) { const float dl = yv[nt][j] - mu[j]; var[j] += dl * dl; }
#pragma unroll
            for (int j = 0; j < 4; ++j) { float sq = var[j]; sq += __shfl_xor(sq, 1); sq += __shfl_xor(sq, 2); sq += __shfl_xor(sq, 4); sq += __shfl_xor(sq, 8); var[j] = rsqrtf(sq * (1.0f / 64.0f) + 64e-5f); }
#pragma unroll
            for (int nt = 0; nt < 4; ++nt) { const int hc = h * 64 + nt * 16 + fr; const float lnw = p.in[I_LNW][hc], lnb = p.in[I_LNB][hc];
#pragma unroll
                for (int j = 0; j < 4; ++j) { const int t = 16 * mt + fq * 4 + j;
                    const float yn = (yv[nt][j] - mu[j]) * var[j] * lnw + lnb;
                    OCAT[(size_t)(g0 + t) * DM + 512 + hc] = f2bf((yn + RSUM[t] * q0[nt][j]) * q2[nt][j]); } }
        }
        RW_SYNC();
    }
}
#undef CONVL
#undef RW_LOAD
#undef RW_SYNC
__device__ __forceinline__ void rwkv_pass_b(const Params& p, LAS unsigned char* lds, int half) {
    const int tid = tid_fresh(), wave = tid >> 6, lane = tid & 63, fr = lane & 15, fq = lane >> 4;
    LAS float* Sb = (LAS float*)lds; LAS float* Pb = Sb + 2 * 64 * 68;
    float* RS = (float*)(p.ws + OFF_RS);
    const int NC = half ? 64 : 4, nchains = half ? 32 : 512;
    const int mt = wave >> 1, nt0 = (wave & 1) * 2;
    const int rrow = tid >> 3, rcol = (tid & 7) * 8;
#define PB_LOADP(P0, P1, EP) do { P0 = *(const f32x4*)((EP) + 4096 + rrow * 64 + rcol); P1 = *(const f32x4*)((EP) + 4096 + rrow * 64 + rcol + 4); } while (0)
#define PB_LOADL(LL, EP) do { _Pragma("unroll") for (int q = 0; q < 2; ++q) _Pragma("unroll") for (int r = 0; r < 4; ++r) LL[q][r] = (EP)[(16 * mt + 4 * fq + r) * 64 + 16 * (nt0 + q) + fr]; } while (0)
    for (int chain = blockIdx.x; chain < nchains; chain += gridDim.x) {
        const int seqh = chain >> 4, h = (chain >> 1) & 7, dir = chain & 1;
        const size_t sidx = (size_t)((seqh * 2 + dir) * 8 + h) * 4096;
        float* E0 = RS + (size_t)(chain * NC) * 8192;
        f32x4 Sr[2];
#pragma unroll
        for (int q = 0; q < 2; ++q)
#pragma unroll
            for (int r = 0; r < 4; ++r) Sr[q][r] = half ? p.in[I_SR][sidx + (16 * mt + 4 * fq + r) * 64 + 16 * (nt0 + q) + fr] : 0.f;
        f32x4 Lc[2], La[2], Lb[2], pa0, pa1, pb0, pb1;
        PB_LOADP(pa0, pa1, E0); PB_LOADL(Lc, E0);
#pragma unroll
        for (int q = 0; q < 2; ++q)
#pragma unroll
            for (int r = 0; r < 4; ++r) Sb[(16 * mt + 4 * fq + r) * 68 + 16 * (nt0 + q) + fr] = Sr[q][r];
        *(LAS f32x4*)(Pb + rrow * 68 + rcol) = pa0; *(LAS f32x4*)(Pb + rrow * 68 + rcol + 4) = pa1;
        if (NC > 1) { PB_LOADP(pa0, pa1, E0 + 8192); PB_LOADL(La, E0 + 8192); }
        asm volatile("s_waitcnt vmcnt(0)" ::: "memory");
        lds_barrier();
        for (int cp = 0; cp < NC; ++cp) {
            float* E = E0 + (size_t)cp * 8192;
            const LAS float* Sc = Sb + (cp & 1) * (64 * 68); const LAS float* Pc = Pb + (cp & 1) * (64 * 68);
            LAS float* Sn = Sb + ((cp + 1) & 1) * (64 * 68); LAS float* Pn = Pb + ((cp + 1) & 1) * (64 * 68);
            f32x4 acc[2] = {Lc[0], Lc[1]};
            if (cp + 2 < NC) { PB_LOADP(pb0, pb1, E + 2 * 8192); PB_LOADL(Lb, E + 2 * 8192); }
#pragma unroll
            for (int q = 0; q < 2; ++q)
#pragma unroll
                for (int r = 0; r < 4; ++r) E[(16 * mt + 4 * fq + r) * 64 + 16 * (nt0 + q) + fr] = Sr[q][r];
#pragma unroll
            for (int kk = 0; kk < 16; ++kk) { const float av = Sc[(16 * mt + fr) * 68 + 4 * kk + fq];
                acc[0] = __builtin_amdgcn_mfma_f32_16x16x4f32(av, Pc[(4 * kk + fq) * 68 + 16 * nt0 + fr], acc[0], 0, 0, 0);
                acc[1] = __builtin_amdgcn_mfma_f32_16x16x4f32(av, Pc[(4 * kk + fq) * 68 + 16 * (nt0 + 1) + fr], acc[1], 0, 0, 0); }
            Sr[0] = acc[0]; Sr[1] = acc[1];
            if (cp + 1 < NC) {
#pragma unroll
                for (int q = 0; q < 2; ++q)
#pragma unroll
                    for (int r = 0; r < 4; ++r) Sn[(16 * mt + 4 * fq + r) * 68 + 16 * (nt0 + q) + fr] = Sr[q][r];
                *(LAS f32x4*)(Pn + rrow * 68 + rcol) = pa0; *(LAS f32x4*)(Pn + rrow * 68 + rcol + 4) = pa1;
                Lc[0] = La[0]; Lc[1] = La[1]; pa0 = pb0; pa1 = pb1; La[0] = Lb[0]; La[1] = Lb[1]; }
            lds_barrier();
        }
        if (!half) {
#pragma unroll
            for (int q = 0; q < 2; ++q)
#pragma unroll
                for (int r = 0; r < 4; ++r) p.out[20971520 + sidx + (16 * mt + 4 * fq + r) * 64 + 16 * (nt0 + q) + fr] = Sr[q][r];
        }
    }
#undef PB_LOADP
#undef PB_LOADL
}
__device__ __forceinline__ float gelu_tanh(float x) { const float u = 0.7978845608f * (x + 0.044715f * x * x * x); return x - x / (1.0f + __expf(2.0f * u)); }
__device__ __forceinline__ void phase_ffn_act(const Params& p) {
    const bf16_t* G = (const bf16_t*)(p.ws + OFF_G); bf16_t* UPp = (bf16_t*)(p.ws + OFF_UP);
    const float* cw = p.in[I_FCONV]; const float* cb = p.in[I_FCB];
    const int gt = blockIdx.x * 512 + tid_fresh(), GT = gridDim.x * 512;
    const int nslot = GT / 352, cgp = gt % 352, tslot = gt / 352, c0 = cgp * 8;
    if (tslot >= nslot) return;
    float w[9][8], bias[8];
#pragma unroll
    for (int k = 0; k < 9; ++k)
#pragma unroll
        for (int e = 0; e < 8; ++e) w[k][e] = cw[(size_t)k * DFF + c0 + e];
#pragma unroll
    for (int e = 0; e < 8; ++e) bias[e] = cb[c0 + e];
    for (int tok0 = tslot; tok0 < NTOK; tok0 += 2 * nslot) {
        bf16x8 gv[2][9], uv[2]; float msk[2][9]; bool live[2];
#pragma unroll
        for (int u = 0; u < 2; ++u) { const int tok = tok0 + u * nslot; live[u] = tok < NTOK; const int tk = live[u] ? tok : tslot;
            const bool ctx = tk < 8192; const int tl = (tk - 8192) & 4095, gr = tl >> 6, gc = tl & 63, pos = tk & 255;
            if (ctx) {
#pragma unroll
                for (int k = 0; k < 9; ++k) { msk[u][k] = 0.0f; gv[u][k] = (bf16x8){0, 0, 0, 0, 0, 0, 0, 0}; }
#pragma unroll
                for (int kw = 0; kw < 3; ++kw) { const bool v = pos + kw - 1 >= 0 && pos + kw - 1 <= 255;
                    msk[u][3 + kw] = v ? 1.0f : 0.0f; gv[u][3 + kw] = *(const bf16x8*)(G + (size_t)(v ? tk + kw - 1 : tk) * DFF + c0); }
            } else {
#pragma unroll
                for (int kh = 0; kh < 3; ++kh)
#pragma unroll
                    for (int kw = 0; kw < 3; ++kw) {
                        const bool v = gr + kh - 1 >= 0 && gr + kh - 1 <= 63 && gc + kw - 1 >= 0 && gc + kw - 1 <= 63;
                        msk[u][kh * 3 + kw] = v ? 1.0f : 0.0f;
                        gv[u][kh * 3 + kw] = *(const bf16x8*)(G + (size_t)(v ? tk + (kh - 1) * 64 + (kw - 1) : tk) * DFF + c0); }
            }
            uv[u] = *(const bf16x8*)(UPp + (size_t)tk * DFF + c0); }
#pragma unroll
        for (int u = 0; u < 2; ++u) { const int tok = tok0 + u * nslot;
            float acc[8];
#pragma unroll
            for (int e = 0; e < 8; ++e) acc[e] = bias[e];
#pragma unroll
            for (int k = 0; k < 9; ++k)
#pragma unroll
                for (int e = 0; e < 8; ++e) acc[e] += (w[k][e] * msk[u][k]) * bf2f((bf16_t)gv[u][k][e]);
            u32x4 o; o.x = pk2(gelu_tanh(acc[0]) * bf2f((bf16_t)uv[u][0]), gelu_tanh(acc[1]) * bf2f((bf16_t)uv[u][1])); o.y = pk2(gelu_tanh(acc[2]) * bf2f((bf16_t)uv[u][2]), gelu_tanh(acc[3]) * bf2f((bf16_t)uv[u][3]));
            o.z = pk2(gelu_tanh(acc[4]) * bf2f((bf16_t)uv[u][4]), gelu_tanh(acc[5]) * bf2f((bf16_t)uv[u][5])); o.w = pk2(gelu_tanh(acc[6]) * bf2f((bf16_t)uv[u][6]), gelu_tanh(acc[7]) * bf2f((bf16_t)uv[u][7]));
            if (live[u]) *(u32x4*)(UPp + (size_t)tok * DFF + c0) = o; }
    }
}

constexpr int LDS_ST = 155648 + 3072;
constexpr int LDS_BYTES = LDS_ST + 16;
__global__ void __launch_bounds__(512, 2) mega(Params p) {
    extern __shared__ __attribute__((aligned(16))) unsigned char shm[];
    LAS unsigned char* lds = (LAS unsigned char*)shm;
    cg::grid_group grid = cg::this_grid();
    const float* mod = (const float*)(p.ws + OFF_MOD);
    bf16_t* H = (bf16_t*)(p.ws + OFF_H);
    pg8::StaticOrder S;
    volatile LAS unsigned* st = (volatile LAS unsigned*)(lds + LDS_ST);
    if (threadIdx.x == 0) { st[0] = 0u; st[1] = 0u; }
    __syncthreads();
    const XcdBarrier xb = xcd_barrier_post((unsigned*)(p.ws + OFF_BAR), st);

#ifndef SK0
    phase0(p, lds);
#endif
    if (p.ws == nullptr) grid.sync();
    xcd_barrier(xb);
    phase_norm_mod(p, nullptr, p.in[I_NMIX], 0, 1024, H);
    xcd_barrier(xb);
    { pg8::Gemm g{H, (const bf16_t*)(p.ws + OFF_WINT), NTOK, PINP, 1024}; S.init(NTOK, PINP, gridDim.x, blockIdx.x);
      pg8::EpiU E{(bf16_t*)(p.ws + OFF_U)};
#ifndef SKG
      pg8::gemm_phase(lds, g, S, E);
#endif
    }
    late_transposes(p, lds, 1088 - 4 * (int)gridDim.x);
    xcd_barrier(xb);
    rwkv_ain_phase(p, lds);
    xcd_barrier(xb);
    for (int half = 0; half < 2; ++half) {
#ifndef SK1
        rwkv_wy<false>(p, lds, half);
#endif
#ifndef SK2
        hgrn_pass_a(p, lds, half);
#endif
        xcd_barrier(xb);
#ifndef SK3
        rwkv_pass_b(p, lds, half);
#endif
#ifndef SK4
        hgrn_pass_b(p, half);
#endif
        xcd_barrier(xb);
#ifndef SK5
        rwkv_wy<true>(p, lds, half);
#endif
#ifndef SK6
        hgrn_pass_c(p, lds, half);
#endif
        xcd_barrier(xb);
    }
    { pg8::Gemm g{H, (const bf16_t*)(p.ws + OFF_WOUTT), NTOK, 1024, 1024}; S.init(NTOK, 1024, gridDim.x, blockIdx.x);
      pg8::EpiRes<true> E{p.out, p.in[I_XP], p.in[I_XS], mod + 2048};
#ifndef SKG
      pg8::gemm_phase(lds, g, S, E);
#endif
    }
    xcd_barrier(xb);
    phase_norm_mod(p, p.out, p.in[I_NFFN], 3072, 4096, H);
    xcd_barrier(xb);
    { pg8::Gemm g{H, (const bf16_t*)(p.ws + OFF_WGUT), NTOK, 2 * DFF, 1024}; S.init(NTOK, 2 * DFF, gridDim.x, blockIdx.x);
      pg8::EpiGU E{(bf16_t*)(p.ws + OFF_G), (bf16_t*)(p.ws + OFF_UP)};
#ifndef SKG
      pg8::gemm_phase(lds, g, S, E);
#endif
    }
    xcd_barrier(xb);
#ifndef SK7
    phase_ffn_act(p);
#endif
    xcd_barrier(xb);
    { pg8::Gemm g{(const bf16_t*)(p.ws + OFF_UP), (const bf16_t*)(p.ws + OFF_WDT), NTOK, 1024, DFF}; S.init(NTOK, 1024, gridDim.x, blockIdx.x);
      pg8::EpiRes<false> E{p.out, p.out, nullptr, mod + 5120};
#ifndef SKG
      pg8::gemm_phase(lds, g, S, E);
#endif
    }
    xcd_barrier(xb);
    phase_final_norm(p);
}

extern "C" void kernel_launch(void* const* d_in, const int* in_sizes, int n_in, void* d_out, int out_size, void* d_ws, size_t ws_size, hipStream_t stream) {
    static int grid_blocks = 0;
    if (grid_blocks == 0) {
        if (n_in != 31 || ws_size < WS_END) { fprintf(stderr, "kernel_launch: unexpected n_in %d / ws %zu (need %zu)\n", n_in, ws_size, (size_t)WS_END); grid_blocks = -1; return; }
        int dev = 0, cus = 0, per_cu = 0;
        hipGetDevice(&dev);
        hipDeviceGetAttribute(&cus, hipDeviceAttributeMultiprocessorCount, dev);
        if (hipFuncSetAttribute((const void*)mega, hipFuncAttributeMaxDynamicSharedMemorySize, LDS_BYTES) != hipSuccess) { fprintf(stderr, "kernel_launch: hipFuncSetAttribute failed\n"); grid_blocks = -1; return; }
        if (hipOccupancyMaxActiveBlocksPerMultiprocessor(&per_cu, (const void*)mega, 512, LDS_BYTES) != hipSuccess || per_cu < 1) { fprintf(stderr, "kernel_launch: occupancy query gave %d\n", per_cu); per_cu = 1; }
        (void)hipGetLastError();
        grid_blocks = cus * per_cu;
        if (grid_blocks > 256) grid_blocks = 256;
    }
    if (grid_blocks < 0) return;
    if (hipMemsetAsync((char*)d_ws + OFF_BAR, 0, 16384, stream) != hipSuccess) { fprintf(stderr, "kernel_launch: memset failed\n"); return; }
    Params p{};
    for (int i = 0; i < 31; ++i) p.in[i] = (const float*)d_in[i];
    p.out = (float*)d_out; p.ws = (unsigned char*)d_ws;
    void* args[] = {&p};
    hipError_t e = hipLaunchCooperativeKernel((const void*)mega, dim3(grid_blocks), dim3(512), args, LDS_BYTES, stream);
    if (e != hipSuccess) fprintf(stderr, "cooperative launch failed: %s (grid %d)\n", hipGetErrorString(e), grid_blocks);
}
```
